# Optimizing an MI355X kernel written in HIP

```python
import math
import jax, jax.numpy as jnp
from jax import lax
import numpy as np

D_MODEL = 2048
BATCH = 16
SEQ = 2048
DEPTH = 2

N_HEADS = 16
N_KV_HEADS = 2
HEAD_DIM = 64
WINDOW = 128
BLOCK = 128
ATTN_WIDTH = N_HEADS * HEAD_DIM
KV_WIDTH = N_KV_HEADS * HEAD_DIM
SSM_WIDTH = D_MODEL // 4
SSM_GROUP = 16
N_SSM_GROUPS = SSM_WIDTH // SSM_GROUP
SSM_STATE = 64
DT_MIN = 1e-3
DT_MAX = 1e-1
N_MEM = 256
MEM_HEADS = 4
MEM_HEAD_DIM = 128
MEM_WIDTH = MEM_HEADS * MEM_HEAD_DIM
N_BRANCHES = 3
MIX_WIDTH = ATTN_WIDTH + SSM_WIDTH + MEM_WIDTH
Q_END = ATTN_WIDTH
K_END = Q_END + KV_WIDTH
V_END = K_END + KV_WIDTH
U_END = V_END + SSM_WIDTH
QM_END = U_END + MEM_WIDTH
IN_WIDTH = QM_END + N_BRANCHES * D_MODEL
N_EXPERTS = 32
TOP_K = 4
D_FF = D_MODEL // 2
MOE_BLOCK = 512
SWIGLU_ALPHA = 1.702
SWIGLU_LIMIT = 7.0
LN_EPS = 1e-5
DEEPNORM_ALPHA = (2.0 * DEPTH) ** 0.25
DEEPNORM_BETA = (8.0 * DEPTH) ** -0.25

kernel_name = "hybrid_swa_s5_memxattn_moe_deepnorm"


def layer_norm(x, g, b):
    xf = x.astype(jnp.float32)
    mu = xf.mean(-1, keepdims=True)
    var = jnp.square(xf - mu).mean(-1, keepdims=True)
    y = (xf - mu) * lax.rsqrt(var + LN_EPS) * g.astype(jnp.float32) + b.astype(jnp.float32)
    return y.astype(x.dtype)


def sliding_window_attention(q, k, v, sinks):
    b, s = q.shape[:2]
    nb = s // BLOCK
    grp = N_HEADS // N_KV_HEADS
    qb = q.reshape(b, nb, BLOCK, N_KV_HEADS, grp, HEAD_DIM)

    def band(t):
        tb = t.reshape(b, nb, BLOCK, N_KV_HEADS, HEAD_DIM)
        prev = jnp.pad(tb[:, :-1], ((0, 0), (1, 0), (0, 0), (0, 0), (0, 0)))
        return jnp.concatenate([prev, tb], axis=2)

    kb, vb = band(k), band(v)
    scores = jnp.einsum('bnqhgd,bnkhd->bnhgqk', qb, kb,
                        preferred_element_type=jnp.float32) * (HEAD_DIM ** -0.5)
    qi = jnp.arange(BLOCK)[:, None]
    kj = jnp.arange(2 * BLOCK)[None, :]
    rel = qi + BLOCK - kj
    band_ok = (rel >= 0) & (rel < WINDOW)
    not_first = (jnp.arange(nb) > 0)[:, None, None]
    valid = band_ok[None] & (not_first | (kj >= BLOCK)[None])
    scores = jnp.where(valid[None, :, None, None], scores, -jnp.inf)
    sink = sinks.astype(jnp.float32).reshape(1, 1, N_KV_HEADS, grp, 1, 1)
    m = jnp.maximum(scores.max(-1, keepdims=True), sink)
    e = jnp.exp(scores - m)
    probs = e / (e.sum(-1, keepdims=True) + jnp.exp(sink - m))
    out = jnp.einsum('bnhgqk,bnkhd->bnqhgd', probs.astype(v.dtype), vb)
    return out.reshape(b, s, ATTN_WIDTH)


def s5_ssm(u, lambda_re, lambda_im, log_dt, b_re, b_im, c_re, c_im, d_skip):
    b, s = u.shape[:2]
    f32 = jnp.float32
    uf = u.astype(f32).reshape(b, s, N_SSM_GROUPS, SSM_GROUP)
    lam = lax.complex(lambda_re.astype(f32), lambda_im.astype(f32))
    dt = jnp.exp(log_dt.astype(f32))[:, None]
    lam_bar = jnp.exp(lam * dt)
    b_mat = lax.complex(b_re.astype(f32), b_im.astype(f32))
    b_bar = ((lam_bar - 1.0) / lam)[..., None] * b_mat
    bu = jnp.einsum('gph,bsgh->bsgp', b_bar, uf.astype(jnp.complex64))

    def combine(left, right):
        a_l, x_l = left
        a_r, x_r = right
        return a_r * a_l, a_r * x_l + x_r

    a = jnp.broadcast_to(lam_bar, bu.shape)
    _, states = lax.associative_scan(combine, (a, bu), axis=1)
    c_mat = lax.complex(c_re.astype(f32), c_im.astype(f32))
    y = jnp.einsum('ghp,bsgp->bsgh', c_mat, states).real + d_skip.astype(f32) * uf
    return y.reshape(b, s, SSM_WIDTH).astype(u.dtype)


def memory_attention(q, mem_k, mem_v):
    b, s = q.shape[:2]
    scores = jnp.einsum('bshd,bmhd->bhsm', q, mem_k,
                        preferred_element_type=jnp.float32) * (MEM_HEAD_DIM ** -0.5)
    probs = jax.nn.softmax(scores, axis=-1).astype(mem_v.dtype)
    return jnp.einsum('bhsm,bmhd->bshd', probs, mem_v).reshape(b, s, MEM_WIDTH)


def mixer(h, mem, w_in, sinks, lambda_re, lambda_im, log_dt, b_re, b_im, c_re, c_im,
          d_skip, w_glu, w_mem_kv, w_branch, w_out):
    b, s, _ = h.shape
    proj = h @ w_in
    q = proj[..., :Q_END].reshape(b, s, N_HEADS, HEAD_DIM)
    k = proj[..., Q_END:K_END].reshape(b, s, N_KV_HEADS, HEAD_DIM)
    v = proj[..., K_END:V_END].reshape(b, s, N_KV_HEADS, HEAD_DIM)
    u = proj[..., V_END:U_END]
    qm = proj[..., U_END:QM_END].reshape(b, s, MEM_HEADS, MEM_HEAD_DIM)
    gates = jax.nn.sigmoid(proj[..., QM_END:].reshape(b, s, N_BRANCHES, D_MODEL))

    attn_out = sliding_window_attention(q, k, v, sinks)

    z = jax.nn.gelu(s5_ssm(u, lambda_re, lambda_im, log_dt, b_re, b_im, c_re, c_im, d_skip))
    zg = z @ w_glu
    ssm_out = zg[..., :SSM_WIDTH] * jax.nn.sigmoid(zg[..., SSM_WIDTH:])

    mem_kv = (mem @ w_mem_kv).reshape(b, N_MEM, 2, MEM_HEADS, MEM_HEAD_DIM)
    mem_out = memory_attention(qm, mem_kv[:, :, 0], mem_kv[:, :, 1])

    br_attn = attn_out @ w_branch[:ATTN_WIDTH]
    br_ssm = ssm_out @ w_branch[ATTN_WIDTH:ATTN_WIDTH + SSM_WIDTH]
    br_mem = mem_out @ w_branch[ATTN_WIDTH + SSM_WIDTH:]
    merged = gates[:, :, 0] * br_attn + gates[:, :, 1] * br_ssm + gates[:, :, 2] * br_mem
    return merged @ w_out


def moe_ffn(h, w_router, b_router, w_up, b_up, w_down, b_down):
    b, s, d = h.shape
    hf = h.reshape(-1, d)
    n_tok = hf.shape[0]
    n_pairs = n_tok * TOP_K
    n_blocks = -(-n_pairs // MOE_BLOCK) + N_EXPERTS
    logits = (hf @ w_router).astype(jnp.float32) + b_router.astype(jnp.float32)
    top_logits, top_idx = lax.top_k(logits, TOP_K)
    gate = jax.nn.softmax(top_logits, axis=-1)
    flat_e = top_idx.reshape(-1)
    order = jnp.argsort(flat_e)
    sorted_e = flat_e[order]
    tok = order // TOP_K
    counts = jnp.bincount(flat_e, length=N_EXPERTS).astype(jnp.int32)
    padded = (counts + MOE_BLOCK - 1) // MOE_BLOCK * MOE_BLOCK
    start = jnp.cumsum(counts) - counts
    pad_end = jnp.cumsum(padded)
    pad_start = pad_end - padded
    dest = pad_start[sorted_e] + jnp.arange(n_pairs, dtype=jnp.int32) - start[sorted_e]
    x_pad = jnp.zeros((n_blocks * MOE_BLOCK, d), hf.dtype).at[dest].set(hf[tok])
    block_rows = jnp.arange(n_blocks, dtype=jnp.int32) * MOE_BLOCK
    block_e = jnp.minimum(jnp.searchsorted(pad_end, block_rows, side='right'),
                          N_EXPERTS - 1).astype(jnp.int32)

    def expert_block(args):
        xb, e = args
        up = xb @ w_up[e] + b_up[e]
        x_glu = jnp.minimum(up[:, ::2], SWIGLU_LIMIT)
        x_lin = jnp.clip(up[:, 1::2], -SWIGLU_LIMIT, SWIGLU_LIMIT)
        act = x_glu * jax.nn.sigmoid(SWIGLU_ALPHA * x_glu) * (x_lin + 1.0)
        return act @ w_down[e] + b_down[e]

    out_pad = lax.map(expert_block, (x_pad.reshape(n_blocks, MOE_BLOCK, d), block_e))
    out = out_pad.reshape(-1, d)[dest] * gate.reshape(-1)[order][:, None].astype(hf.dtype)
    y = jax.ops.segment_sum(out, tok, num_segments=n_tok)
    return y.reshape(b, s, d)


def setup_inputs(seed: int = 0) -> dict:
    key = jax.random.key(seed)
    ks = jax.random.split(key, 32)
    L, D, G, P, H = DEPTH, D_MODEL, N_SSM_GROUPS, SSM_STATE, SSM_GROUP
    nrm = jax.random.normal
    branch_row_scale = jnp.concatenate([
        jnp.full((ATTN_WIDTH,), ATTN_WIDTH ** -0.5, jnp.float32),
        jnp.full((SSM_WIDTH,), SSM_WIDTH ** -0.5, jnp.float32),
        jnp.full((MEM_WIDTH,), MEM_WIDTH ** -0.5, jnp.float32)])
    return {
        "x": nrm(ks[0], (BATCH, SEQ, D), jnp.float32),
        "mem": nrm(ks[1], (BATCH, N_MEM, D), jnp.float32),
        "ln_in_g": 1.0 + 0.02 * nrm(ks[2], (D,), jnp.float32),
        "ln_in_b": 0.02 * nrm(ks[3], (D,), jnp.float32),
        "w_in": nrm(ks[4], (L, D, IN_WIDTH), jnp.float32) * D ** -0.5,
        "attn_sinks": 0.5 * nrm(ks[5], (L, N_HEADS), jnp.float32),
        "ssm_lambda_re": -0.5 + 0.01 * nrm(ks[6], (L, G, P), jnp.float32),
        "ssm_lambda_im": jnp.pi * jnp.arange(P, dtype=jnp.float32) + 0.01 * nrm(ks[7], (L, G, P), jnp.float32),
        "ssm_log_dt": jax.random.uniform(ks[8], (L, G), jnp.float32, math.log(DT_MIN), math.log(DT_MAX)),
        "ssm_b_re": nrm(ks[9], (L, G, P, H), jnp.float32) * (2 * H) ** -0.5,
        "ssm_b_im": nrm(ks[10], (L, G, P, H), jnp.float32) * (2 * H) ** -0.5,
        "ssm_c_re": nrm(ks[11], (L, G, H, P), jnp.float32) * P ** -0.5,
        "ssm_c_im": nrm(ks[12], (L, G, H, P), jnp.float32) * P ** -0.5,
        "ssm_d": nrm(ks[13], (L, G, H), jnp.float32),
        "w_glu": nrm(ks[14], (L, SSM_WIDTH, 2 * SSM_WIDTH), jnp.float32) * SSM_WIDTH ** -0.5,
        "w_mem_kv": nrm(ks[15], (L, D, 2 * MEM_WIDTH), jnp.float32) * D ** -0.5,
        "w_branch": nrm(ks[16], (L, MIX_WIDTH, D), jnp.float32) * branch_row_scale[None, :, None],
        "w_out": nrm(ks[17], (L, D, D), jnp.float32) * (D ** -0.5 * DEEPNORM_BETA),
        "ln1_g": 1.0 + 0.02 * nrm(ks[18], (L, D), jnp.float32),
        "ln1_b": 0.02 * nrm(ks[19], (L, D), jnp.float32),
        "w_router": nrm(ks[20], (L, D, N_EXPERTS), jnp.float32) * D ** -0.5,
        "b_router": 0.01 * nrm(ks[21], (L, N_EXPERTS), jnp.float32),
        "w_up": nrm(ks[22], (L, N_EXPERTS, D, 2 * D_FF), jnp.float32) * D ** -0.5,
        "b_up": 0.01 * nrm(ks[23], (L, N_EXPERTS, 2 * D_FF), jnp.float32),
        "w_down": nrm(ks[24], (L, N_EXPERTS, D_FF, D), jnp.float32) * (D_FF ** -0.5 * DEEPNORM_BETA),
        "b_down": 0.01 * nrm(ks[25], (L, N_EXPERTS, D), jnp.float32),
        "ln2_g": 1.0 + 0.02 * nrm(ks[26], (L, D), jnp.float32),
        "ln2_b": 0.02 * nrm(ks[27], (L, D), jnp.float32),
    }


def reference(x, mem, ln_in_g, ln_in_b, w_in, attn_sinks, ssm_lambda_re, ssm_lambda_im,
              ssm_log_dt, ssm_b_re, ssm_b_im, ssm_c_re, ssm_c_im, ssm_d, w_glu, w_mem_kv,
              w_branch, w_out, ln1_g, ln1_b, w_router, b_router, w_up, b_up, w_down, b_down,
              ln2_g, ln2_b):
    h = layer_norm(x, ln_in_g, ln_in_b)
    for l in range(DEPTH):
        mix = mixer(h, mem, w_in[l], attn_sinks[l], ssm_lambda_re[l], ssm_lambda_im[l],
                    ssm_log_dt[l], ssm_b_re[l], ssm_b_im[l], ssm_c_re[l], ssm_c_im[l],
                    ssm_d[l], w_glu[l], w_mem_kv[l], w_branch[l], w_out[l])
        h = layer_norm(DEEPNORM_ALPHA * h + mix, ln1_g[l], ln1_b[l])
        ffn = moe_ffn(h, w_router[l], b_router[l], w_up[l], b_up[l], w_down[l], b_down[l])
        h = layer_norm(DEEPNORM_ALPHA * h + ffn, ln2_g[l], ln2_b[l])
    return h
```

```cpp
#include <hip/hip_runtime.h>
#include <cstdio>
#include <cstdint>

#ifndef PROBE_VARIANT
#define PROBE_VARIANT 0
#endif
#ifndef MK_PER_PHASE
#define MK_PER_PHASE 0
#endif

#define GAS __attribute__((address_space(1)))
#define LAS __attribute__((address_space(3)))
typedef unsigned short bf16;
typedef short bf16x8 __attribute__((ext_vector_type(8)));
typedef short bf16x16 __attribute__((ext_vector_type(16)));
typedef float f32x4 __attribute__((ext_vector_type(4)));
typedef float f32x2 __attribute__((ext_vector_type(2)));
typedef unsigned u32x4 __attribute__((ext_vector_type(4)));
typedef unsigned u32x2 __attribute__((ext_vector_type(2)));
typedef __bf16 bf16x2_t __attribute__((ext_vector_type(2)));
typedef int i32x8 __attribute__((ext_vector_type(8)));

constexpr int T = 32768, D = 2048, NL = 2, SEQ = 2048, NBATCH = 16;
constexpr int INW = 8448, NE = 32, DFF = 1024, NMEM = 256;
constexpr int NWAVES = 8, NTHR = 512;
constexpr float LN_EPS = 1e-5f;
constexpr float DN_ALPHA = 1.4142135623730951f;
constexpr int PADROWS = 139264;
constexpr int LCH = 32, NCH = SEQ / LCH;
constexpr int UK = 640;

constexpr size_t WS_CTL  = 0, CTL_ZERO_BYTES = 1u << 20;
constexpr size_t WS_WIN  = 1u << 20;
constexpr size_t WS_WIN8 = WS_WIN + (size_t)2 * 2304 * D * 2;
constexpr size_t WS_WGLU = WS_WIN  + (size_t)2 * INW * D * 2;
constexpr size_t WS_WMKV = WS_WGLU + (size_t)2 * 1024 * 512 * 2;
constexpr size_t WS_WBR  = WS_WMKV + (size_t)2 * 1024 * D * 2;
constexpr size_t WS_WOUT = WS_WBR  + (size_t)2 * D * D * 2;
constexpr size_t WS_WUP  = WS_WOUT + (size_t)2 * D * D * 2;
constexpr size_t WS_WDN  = WS_WUP  + (size_t)2 * NE * D * D * 2;
constexpr size_t WS_WRT  = WS_WDN  + (size_t)2 * NE * D * DFF * 2;
constexpr size_t WS_W1S  = WS_WRT  + (size_t)2 * 2 * NE * D * 2;
constexpr size_t WS_WST  = WS_W1S  + (size_t)2 * 32 * 512 * UK * 2;
constexpr size_t WS_LAM  = WS_WST  + (size_t)2 * 32 * 256 * 512 * 2;
constexpr size_t WS_H32  = WS_LAM  + (size_t)2 * 32 * 64 * 8;
constexpr size_t WS_H8   = WS_H32;
constexpr size_t WS_H4   = WS_H32 + (size_t)T * D;
constexpr size_t WS_WIN4 = WS_WIN + (size_t)2 * INW * D;
constexpr size_t WS_HB   = WS_H32  + (size_t)T * D * 4;
constexpr size_t WS_MEMB = WS_HB   + (size_t)T * D * 2;
constexpr size_t WS_Q    = WS_MEMB + (size_t)4096 * D * 2;
constexpr size_t WS_KV   = WS_Q    + (size_t)T * 1024 * 2;
constexpr size_t WS_U    = WS_KV   + (size_t)T * 256 * 2;
constexpr size_t WS_QM   = WS_U    + (size_t)32 * 1024 * UK * 2;
constexpr size_t WS_G    = WS_QM   + (size_t)T * 512 * 2;
constexpr size_t WS_MKV  = WS_G    + (size_t)T * 6144 * 2;
constexpr size_t WS_MIX  = WS_MKV  + (size_t)4096 * 2048 * 2;
constexpr size_t WS_Z    = WS_MIX  + (size_t)T * 2048 * 2;
constexpr size_t WS_S    = WS_Z    + (size_t)T * 512 * 2;
constexpr size_t WS_MRG  = WS_S    + (size_t)32 * 1024 * 128 * 4;
constexpr size_t WS_ACT  = WS_MRG  + (size_t)T * 2048 * 2;
constexpr size_t WS_OP   = WS_ACT  + (size_t)PADROWS * 1024 * 2;
constexpr size_t WS_PE   = WS_OP   + (size_t)PADROWS * 2048 * 2;
constexpr size_t WS_PS   = WS_PE   + (size_t)T * 4 * 4;
constexpr size_t WS_PG   = WS_PS   + (size_t)T * 4 * 4;
constexpr size_t WS_LIST = WS_PG   + (size_t)T * 4 * 4;
constexpr size_t WS_RS   = WS_LIST + (size_t)32 * 32768 * 4;
constexpr size_t WS_END  = WS_RS + (size_t)T * 8;

constexpr int CW_TMO = 0, CW_CODE = 1;
constexpr int CW_BAR = 4096;
constexpr int CW_CNT = 16384;
constexpr int CW_TQ = 24576;

constexpr int RING_BYTES = 139264;
constexpr int MISC_OFF = RING_BYTES;
constexpr int LDS_BYTES = 147456;
constexpr int MO_BAR = 0, MO_CNT = 64, MO_TST = 192, MO_NT = 352, MO_TE = 512;

#define LDS_WAIT() asm volatile("s_waitcnt lgkmcnt(0)" ::: "memory")
#define VM_WAIT() asm volatile("s_waitcnt vmcnt(0)" ::: "memory")
#define RLX_AGENT __ATOMIC_RELAXED, __HIP_MEMORY_SCOPE_AGENT
__device__ __forceinline__ unsigned pk2(float a, float b) { f32x2 v = {a, b}; bf16x2_t r = __builtin_convertvector(v, bf16x2_t); return __builtin_bit_cast(unsigned, r); }
__device__ __forceinline__ u32x4 pack8(const f32x4 a, const f32x4 b) { u32x4 w; w.x = pk2(a[0], a[1]); w.y = pk2(a[2], a[3]); w.z = pk2(b[0], b[1]); w.w = pk2(b[2], b[3]); return w; }
__device__ __forceinline__ unsigned pk_fp8x4(float a, float b, float c, float d) {
    a = fminf(fmaxf(a, -448.f), 448.f); b = fminf(fmaxf(b, -448.f), 448.f); c = fminf(fmaxf(c, -448.f), 448.f); d = fminf(fmaxf(d, -448.f), 448.f);
    unsigned w = 0u; w = __builtin_amdgcn_cvt_pk_fp8_f32(a, b, w, false); w = __builtin_amdgcn_cvt_pk_fp8_f32(c, d, w, true); return w; }
constexpr float FP4_SA = 2.0f, FP4_SW = 2.0f * 45.254833995939045f, FP4_DESCALE = 1.0f / (FP4_SA * FP4_SW);
__device__ __forceinline__ unsigned pk_fp4x8(const f32x4 a, const f32x4 b, float sc) { unsigned w = 0u;
    w = __builtin_amdgcn_cvt_scalef32_pk_fp4_f32(w, a[0] * sc, a[1] * sc, 1.0f, 0); w = __builtin_amdgcn_cvt_scalef32_pk_fp4_f32(w, a[2] * sc, a[3] * sc, 1.0f, 1);
    w = __builtin_amdgcn_cvt_scalef32_pk_fp4_f32(w, b[0] * sc, b[1] * sc, 1.0f, 2); w = __builtin_amdgcn_cvt_scalef32_pk_fp4_f32(w, b[2] * sc, b[3] * sc, 1.0f, 3); return w; }
constexpr float FP8_SO = 64.0f;
constexpr float FP8_SA = 8.0f, FP8_SW = 512.0f, FP8_DESCALE = 1.0f / (8.0f * 512.0f);
__device__ __forceinline__ float bf2f(unsigned short h) { return __builtin_bit_cast(float, (unsigned)h << 16); }
__device__ __forceinline__ float bflo(unsigned w) { return __builtin_bit_cast(float, w << 16); }
__device__ __forceinline__ float bfhi(unsigned w) { return __builtin_bit_cast(float, w & 0xffff0000u); }
__device__ __forceinline__ float fsigmoid(float x) { return __builtin_amdgcn_rcpf(1.0f + __expf(-x)); }
__device__ __forceinline__ float shx(float v, int m, int lane) { return __builtin_bit_cast(float, __builtin_amdgcn_ds_bpermute((lane ^ m) << 2, __builtin_bit_cast(int, v))); }
__device__ __forceinline__ float wave_sum(float v, int lane) {
#pragma unroll
    for (int o = 1; o < 64; o <<= 1) v += shx(v, o, lane);
    return v;
}

#define XB_TMO      128
#define XB_XCNT(j)  (256  + 64 * (j))
#define XB_XSUB(j)  (1280 + 64 * (j))
#define XB_XGEN(j)  (2304 + 64 * (j))
#define XB_TOP      3328
#define XB_TOPGEN   3392
#define XCD_BAR_WORDS 3456
#define XB_SPIN_CAP (1u << 18)

__device__ __forceinline__ unsigned xb_ld(unsigned* p)              { return __hip_atomic_load(p, __ATOMIC_RELAXED, __HIP_MEMORY_SCOPE_AGENT); }
__device__ __forceinline__ unsigned xb_add(unsigned* p, unsigned v) { return __hip_atomic_fetch_add(p, v, __ATOMIC_RELAXED, __HIP_MEMORY_SCOPE_AGENT); }
__device__ __forceinline__ unsigned xb_xcc_id() { return (unsigned)__builtin_amdgcn_s_getreg((3 << 11) | 20) & 0xFu; }
#define XB_SPIN(cond, bar) do { unsigned _sp = 0; while (cond) { __builtin_amdgcn_s_sleep(1); \
    if ((++_sp & 255u) == 0u) { if (xb_ld(&(bar)[XB_TMO])) break; if (_sp > XB_SPIN_CAP) { atomicAdd(&(bar)[XB_TMO], 1u); break; } } } } while (0)

struct XcdBarrier { unsigned* bar; unsigned x; volatile LAS unsigned* st; };

__device__ __forceinline__ XcdBarrier xcd_barrier_post(unsigned* bar, volatile LAS unsigned* st) {
    XcdBarrier b; b.bar = bar; b.x = xb_xcc_id(); b.st = st;
    if (threadIdx.x == 0) (void)xb_add(&bar[XB_XCNT(b.x)], 1u);
    return b;
}
__device__ __forceinline__ void xcd_barrier_complete(unsigned* bar, unsigned x, unsigned& nloc, unsigned& nx) {
    const unsigned G = gridDim.x * gridDim.y * gridDim.z;
    unsigned sum, cnt, mine, sp = 0u;
    for (;;) {
        sum = 0u; cnt = 0u; mine = 0u;
#pragma unroll
        for (unsigned j = 0; j < 16; ++j) { const unsigned c = xb_ld(&bar[XB_XCNT(j)]); sum += c; cnt += (c > 0u) ? 1u : 0u; mine = (j == x) ? c : mine; }
        if (sum == G) break;
        __builtin_amdgcn_s_sleep(1);
        if ((++sp & 255u) == 0u) { if (xb_ld(&bar[XB_TMO])) break; if (sp > XB_SPIN_CAP) { atomicAdd(&bar[XB_TMO], 1u); break; } }
    }
    nloc = mine > 0u ? mine : 1u; nx = cnt > 0u ? cnt : 1u;
}
__device__ __forceinline__ void xcd_barrier(const XcdBarrier& b) {
    asm volatile("s_waitcnt vmcnt(0)" ::: "memory");
    __syncthreads();
    if (threadIdx.x == 0) {
        unsigned* bar = b.bar;
        __builtin_amdgcn_s_waitcnt(0);
        unsigned nloc = b.st[0], nx = b.st[1];
        if (nloc == 0u) { xcd_barrier_complete(bar, b.x, nloc, nx); b.st[0] = nloc; b.st[1] = nx; }
        const unsigned old = xb_add(&bar[XB_XSUB(b.x)], 1u);
        const unsigned gen = old / nloc;
        if (old + 1u == (gen + 1u) * nloc) {
            __builtin_amdgcn_fence(__ATOMIC_RELEASE, "agent");
            asm volatile("s_waitcnt vmcnt(0)" ::: "memory");
            const unsigned og = xb_add(&bar[XB_TOP], 1u);
            const unsigned tg = og / nx;
            if (og + 1u == (tg + 1u) * nx) xb_add(&bar[XB_TOPGEN], 1u);
            else XB_SPIN(xb_ld(&bar[XB_TOPGEN]) == tg, bar);
            __builtin_amdgcn_fence(__ATOMIC_ACQUIRE, "agent");
            xb_add(&bar[XB_XGEN(b.x)], 1u);
            asm volatile("s_waitcnt vmcnt(0)" ::: "memory");
        } else {
            XB_SPIN(xb_ld(&bar[XB_XGEN(b.x)]) == gen, bar);
            __builtin_amdgcn_fence(__ATOMIC_ACQUIRE, "agent");
            asm volatile("s_waitcnt vmcnt(0)" ::: "memory");
        }
    }
    __syncthreads();
}

namespace pg8 {
constexpr int BM = 256, BK = 64, HALF = 128, HTB = HALF * BK * 2, STAGE_BYTES = 8 * HTB, NXCD = 8, WGM = 8;
__host__ __device__ __forceinline__ int lds_byte(int r, int c) { const int st = (r >> 4) * 2 + (c >> 5), rr = r & 15, cc = c & 31, ob = rr * 64 + cc * 2; return st * 1024 + (ob ^ (((ob >> 9) & 1) << 5)); }
__host__ __device__ __forceinline__ void stage_rc(int b, int& R, int& C) { const int st = b / 1024, sb = b % 1024, swz = sb ^ (((sb >> 9) & 1) << 5); R = (st >> 1) * 16 + swz / 64; C = (st & 1) * 32 + (swz % 64) / 2; }
__host__ __device__ __forceinline__ int perm32(int rho) { const int n = rho >> 4, i = rho & 15; return 8 * (i >> 2) + 4 * n + (i & 3); }

struct GUnit { const char* A; const char* B; int nt, keep, pm, pn, aux, slot; };

__device__ __forceinline__ void tile_map(int L, int nM, int nN, int& pm, int& pn) {
    const int nwg = nM * nN; int wgid = L;
    { const int q = nwg / NXCD, r = nwg % NXCD, xcd = wgid % NXCD, off = wgid / NXCD; wgid = (xcd < r ? xcd * (q + 1) : r * (q + 1) + (xcd - r) * q) + off; }
    const int nig = WGM * nN, gid = wgid / nig, fm = gid * WGM, gsz = (nM - fm) < WGM ? (nM - fm) : WGM;
    pm = fm + ((wgid % nig) % gsz); pn = (wgid % nig) / gsz;
}

template <class P>
__device__ __forceinline__ void gemm_phase(LAS unsigned char* lds, const P& Pb) {
    int tid = threadIdx.x; asm volatile("" : "+v"(tid));
    const int wid = __builtin_amdgcn_readfirstlane(tid >> 6), lane = tid & 63, wr = wid >> 2, wc = wid & 3, fr = lane & 15, fq = lane >> 4;
    const unsigned lda = Pb.lda, ldb = Pb.ldb;
    unsigned voffA[2], voffB[2]; int RA[2], CA[2];
#pragma unroll
    for (int i = 0; i < 2; ++i) { int R, C; stage_rc(tid * 16 + i * 8192, R, C); const int p32 = perm32(R & 31), Rb = (R >> 5) * 64 + (p32 >> 3) * 16 + (p32 & 7);
        RA[i] = R; CA[i] = C; voffA[i] = (unsigned)R * lda + (unsigned)C * 2u; voffB[i] = (unsigned)Rb * ldb + (unsigned)C * 2u; }
    const size_t kstep = (size_t)(BK * 2);
    const size_t hstepA = P::GATHER ? (size_t)0 : (size_t)HALF * lda;
    const size_t hstepB = (size_t)8 * ldb;
    const unsigned ldsw = (unsigned)wid * 1024u;
    const int aoff = lds_byte(wr * 64 + fr, fq * 8), boff = lds_byte(wc * 32 + fr, fq * 8);
#define PG8_SA(b, h) (((b) * 2 + (h)) * HTB)
#define PG8_SB(b, h) ((4 + (b) * 2 + (h)) * HTB)
#define PG8_STAGE(bufoff, gbase, voff) do { if (PROBE_VARIANT == 5 && Pb.probe_) break; _Pragma("unroll") for (int _i = 0; _i < 2; ++_i) \
        __builtin_amdgcn_global_load_lds((const unsigned*)((const char*)(gbase) + (voff)[_i]), (LAS unsigned*)(lds + (bufoff) + ldsw + _i * 8192), 16, 0, 0); } while (0)
#define PG8_LDA(dst, b, h) do { _Pragma("unroll") for (int m = 0; m < 4; ++m) _Pragma("unroll") for (int k = 0; k < 2; ++k) dst[m][k] = *(const LAS bf16x8*)(lds + PG8_SA(b, h) + aoff + m * 2048 + k * 1024); } while (0)
#define PG8_LDB(dst, b, h) do { _Pragma("unroll") for (int n = 0; n < 2; ++n) _Pragma("unroll") for (int k = 0; k < 2; ++k) dst[n][k] = *(const LAS bf16x8*)(lds + PG8_SB(b, h) + boff + n * 2048 + k * 1024); } while (0)
#define PG8_CAT(x) __builtin_bit_cast(i32x8, __builtin_shufflevector(__builtin_bit_cast(u32x4, (x)[0]), __builtin_bit_cast(u32x4, (x)[1]), 0, 1, 2, 3, 4, 5, 6, 7))
#define PG8_MMA(ai, bj, At, Bt) do { if (PROBE_VARIANT == 4 && Pb.probe_ && (ai) == 1) break; __builtin_amdgcn_s_setprio(1); \
        if constexpr (P::FP4) { _Pragma("unroll") for (int k = 0; k < 2; ++k) _Pragma("unroll") for (int m = 0; m < 4; ++m) _Pragma("unroll") for (int n = 0; n < 2; ++n) \
            asm volatile("v_mfma_scale_f32_16x16x128_f8f6f4 %0, %1, %2, %0, %3, %3 op_sel_hi:[0,0,0] cbsz:4 blgp:4" : "+v"(acc[ai][bj][m][n]) : "v"(Bt[n][k]), "v"(At[m][k]), "v"(mx_one)); } \
        else if constexpr (P::FP8) { _Pragma("unroll") for (int m = 0; m < 4; ++m) _Pragma("unroll") for (int n = 0; n < 2; ++n) \
            asm volatile("v_mfma_scale_f32_16x16x128_f8f6f4 %0, %1, %2, %0, %3, %3 op_sel_hi:[0,0,0]" : "+v"(acc[ai][bj][m][n]) : "v"(PG8_CAT(Bt[n])), "v"(PG8_CAT(At[m])), "v"(mx_one)); } \
        else { _Pragma("unroll") for (int m = 0; m < 4; ++m) _Pragma("unroll") for (int n = 0; n < 2; ++n) _Pragma("unroll") for (int k = 0; k < 2; ++k) \
            acc[ai][bj][m][n] = __builtin_amdgcn_mfma_f32_16x16x32_bf16(Bt[n][k], At[m][k], acc[ai][bj][m][n], 0, 0, 0); } \
        __builtin_amdgcn_s_setprio(0); } while (0)
#define PG8_WAIT_V(n) asm volatile("s_waitcnt vmcnt(" #n ")" ::: "memory")
#define PG8_WAIT_L(n) asm volatile("s_waitcnt lgkmcnt(" #n ")" ::: "memory")
#define PG8_BAR __builtin_amdgcn_s_barrier()
#define PG8_SCHED __builtin_amdgcn_sched_barrier(0)
    const unsigned mx_one = 0x7f7f7f7fu; (void)mx_one;
    GUnit cur, nxt; int ui = 0;
    if (!Pb.next(0, cur)) return;
    unsigned gC0[2] = {0u, 0u}, gC1[2] = {0u, 0u}, gN0[2] = {0u, 0u}, gN1[2] = {0u, 0u};
    if constexpr (P::GATHER) { Pb.gather(cur, RA, CA, gC0, gC1); }
    f32x4 acc[2][2][4][2]; float zz = 0.f; asm volatile("" : "+v"(zz));
#pragma unroll
    for (int a = 0; a < 2; ++a)
#pragma unroll
        for (int b = 0; b < 2; ++b)
#pragma unroll
            for (int m = 0; m < 4; ++m)
#pragma unroll
                for (int n = 0; n < 2; ++n) acc[a][b][m][n] = (f32x4){zz, zz, zz, zz};
    bf16x8 At[4][2], B0[2][2], B1[2][2];
    const char* cA = cur.A; const char* cB = cur.B;
#define PG8_STAGE_A(bufoff, kptr, h, o0, o1) do { if constexpr (P::GATHER) { if ((h) == 0) PG8_STAGE(bufoff, kptr, o0); else PG8_STAGE(bufoff, kptr, o1); } \
        else { PG8_STAGE(bufoff, (kptr) + (h) * hstepA, voffA); } } while (0)
    PG8_STAGE(PG8_SB(0, 0), cB, voffB); PG8_STAGE(PG8_SB(0, 1), cB + hstepB, voffB); PG8_STAGE_A(PG8_SA(0, 0), cA, 0, gC0, gC1); PG8_STAGE_A(PG8_SA(0, 1), cA, 1, gC0, gC1);
    if (wr == 1) PG8_BAR;
    PG8_WAIT_V(2); PG8_BAR;
    PG8_STAGE(PG8_SB(1, 0), cB + kstep, voffB); PG8_STAGE_A(PG8_SA(1, 0), cA + kstep, 0, gC0, gC1); PG8_STAGE(PG8_SB(1, 1), cB + hstepB + kstep, voffB);
    PG8_WAIT_V(6); PG8_BAR;
    for (;;) {
        const bool has_next = Pb.next(ui + 1, nxt);
        if constexpr (P::GATHER) { if (has_next) Pb.gather_issue(nxt, RA, (LAS unsigned*)(lds + STAGE_BYTES + wid * 1024)); }
        if constexpr (P::RELAX == 2) { if (wid == 0) { int l_ = lane; asm volatile("" : "+v"(l_)); Pb.bias_issue(cur, l_); } }
        const char* nA = has_next ? nxt.A : cA; const char* nB = has_next ? nxt.B : cB;
        int nt = cur.nt; asm volatile("" : "+s"(nt));
        for (int t = 0; t < nt; t += 2) {
            const bool last = (t == nt - 2);
            const bool fresh = P::RELAX && t == 0 && ui > 0;
            const char* a1 = cA + (size_t)(t + 1) * kstep;
            const char* a2 = last ? nA : cA + (size_t)(t + 2) * kstep; const char* b2 = last ? nB : cB + (size_t)(t + 2) * kstep;
            const char* a3 = a2 + kstep; const char* b3 = b2 + kstep;
            unsigned s0[2], s1[2];
            { const bool usen = last && has_next;
              if constexpr (P::GATHER) { if (usen) { const LAS unsigned* gs = (const LAS unsigned*)(lds + STAGE_BYTES + wid * 1024) + lane;
                  gN0[0] = gs[0] * lda + (unsigned)CA[0] * 2u; gN1[0] = gs[64] * lda + (unsigned)CA[0] * 2u; gN0[1] = gs[128] * lda + (unsigned)CA[1] * 2u; gN1[1] = gs[192] * lda + (unsigned)CA[1] * 2u; } }
              s0[0] = usen ? gN0[0] : gC0[0]; s0[1] = usen ? gN0[1] : gC0[1]; s1[0] = usen ? gN1[0] : gC1[0]; s1[1] = usen ? gN1[1] : gC1[1]; }
            PG8_LDB(B0, 0, 0); PG8_LDB(B1, 0, 1); PG8_SCHED; PG8_LDA(At, 0, 0); if (!fresh) { PG8_STAGE_A(PG8_SA(1, 1), a1, 1, gC0, gC1); PG8_WAIT_V(8); } else if (P::RELAX == 2) PG8_WAIT_V(16);
            PG8_WAIT_L(0); PG8_BAR; PG8_MMA(0, 0, At, B0); PG8_MMA(0, 1, At, B1); PG8_BAR; PG8_SCHED;
            PG8_LDA(At, 0, 1); PG8_STAGE(PG8_SB(0, 0), b2, voffB); PG8_STAGE(PG8_SB(0, 1), b2 + hstepB, voffB); PG8_STAGE_A(PG8_SA(0, 0), a2, 0, s0, s1);
            if (!fresh) PG8_WAIT_V(8); else if (P::RELAX == 2) PG8_WAIT_V(16);
            PG8_WAIT_L(0); PG8_BAR; PG8_MMA(1, 0, At, B0); PG8_MMA(1, 1, At, B1); PG8_BAR; PG8_SCHED;
            PG8_LDB(B0, 1, 0); PG8_LDB(B1, 1, 1); PG8_SCHED; PG8_LDA(At, 1, 0); PG8_STAGE_A(PG8_SA(0, 1), a2, 1, s0, s1);
            if (!fresh) PG8_WAIT_V(8); else if (P::RELAX == 16 || P::RELAX == 2) PG8_WAIT_V(16); else if (P::RELAX == 24) PG8_WAIT_V(24);
            PG8_WAIT_L(0); PG8_BAR; PG8_MMA(0, 0, At, B0); PG8_MMA(0, 1, At, B1); PG8_BAR; PG8_SCHED;
            PG8_LDA(At, 1, 1); PG8_STAGE(PG8_SB(1, 0), b3, voffB); PG8_STAGE(PG8_SB(1, 1), b3 + hstepB, voffB); PG8_STAGE_A(PG8_SA(1, 0), a3, 0, s0, s1);
            PG8_WAIT_V(8); PG8_WAIT_L(0); PG8_BAR; PG8_MMA(1, 0, At, B0); PG8_MMA(1, 1, At, B1); PG8_BAR; PG8_SCHED;
        }
        if (wr == 0) PG8_BAR;
        auto hoist = [&]() { if constexpr (P::RELAX != 0) { asm volatile("" ::: "memory"); if (has_next) { PG8_STAGE_A(PG8_SA(1, 1), nA + kstep, 1, gN0, gN1); } asm volatile("" ::: "memory"); } };
        if constexpr (P::FP8 || P::FP4) asm volatile("s_nop 15\n\ts_nop 15" ::: "memory");
        { int fr_ = fr, fq_ = fq, wr_ = wr, wc_ = wc; asm volatile("" : "+v"(fr_), "+v"(fq_)); asm volatile("" : "+s"(wr_), "+s"(wc_));
          Pb.epi(acc, cur, wr_, wc_, fr_, fq_, hoist); }
        if (!has_next) break;
        if (!nxt.keep) {
#pragma unroll
            for (int a = 0; a < 2; ++a)
#pragma unroll
                for (int b = 0; b < 2; ++b)
#pragma unroll
                    for (int m = 0; m < 4; ++m)
#pragma unroll
                        for (int n = 0; n < 2; ++n) acc[a][b][m][n] = (f32x4){0.f, 0.f, 0.f, 0.f};
        }
        cur = nxt; cA = nA; cB = nB; ++ui;
        if constexpr (P::GATHER) { gC0[0] = gN0[0]; gC0[1] = gN0[1]; gC1[0] = gN1[0]; gC1[1] = gN1[1]; }
        if (wr == 1) PG8_BAR;
    }
    PG8_WAIT_V(0);
    PG8_BAR;
#undef PG8_SA
#undef PG8_SB
#undef PG8_STAGE
#undef PG8_STAGE_A
#undef PG8_LDA
#undef PG8_LDB
#undef PG8_MMA
#undef PG8_CAT
#undef PG8_WAIT_V
#undef PG8_WAIT_L
#undef PG8_BAR
#undef PG8_SCHED
}
}
using pg8::GUnit;

struct Frame {
    LAS unsigned char* lds;
    volatile LAS unsigned* MISC;
    unsigned* ctl;
    int tid, lane, wave, vcu, G;
    unsigned char* ws;
};
struct Args { const float* in[28]; float* out; unsigned char* ws; int ph_lo, ph_hi; };

__device__ __forceinline__ int glu_rowmap(int s) { const int part = s >> 9, o = s & 511; return 256 * (o >> 7) + 64 * ((o >> 5) & 3) + 16 * ((o >> 3) & 3) + 8 * part + (o & 7); }
__device__ __forceinline__ void p0_transpose_item_fp8(const float* W, int K, int N, int ldw, unsigned char* WT, LAS float* scr, int item, int lane) {
    const int nblk = N / 32, kb = item / nblk, nb = item % nblk, k0 = 64 * kb, n0 = 32 * nb;
#pragma unroll
    for (int i = 0; i < 32; ++i) { const int kk = 2 * i + (lane >> 5); scr[kk * 33 + (lane & 31)] = W[(size_t)(k0 + kk) * ldw + n0 + (lane & 31)]; }
    LDS_WAIT(); asm volatile("" ::: "memory");
    const int c = lane & 7;
#pragma unroll
    for (int j = 0; j < 4; ++j) { const int n = (lane >> 3) + 8 * j; const LAS float* sp = scr + (8 * c) * 33 + n;
        u32x2 o; o.x = pk_fp8x4(sp[0 * 33] * FP8_SW, sp[1 * 33] * FP8_SW, sp[2 * 33] * FP8_SW, sp[3 * 33] * FP8_SW); o.y = pk_fp8x4(sp[4 * 33] * FP8_SW, sp[5 * 33] * FP8_SW, sp[6 * 33] * FP8_SW, sp[7 * 33] * FP8_SW);
        *(u32x2*)(WT + (size_t)(n0 + n) * K + k0 + 8 * c) = o; }
    LDS_WAIT(); asm volatile("" ::: "memory");
}
__device__ __forceinline__ void p0_transpose_item(const float* W, int K, int N, int ldw, bf16* WT, int glu, LAS float* scr, int item, int lane) {
    const int nblk = N / 32, kb = item / nblk, nb = item % nblk, k0 = 64 * kb, n0 = 32 * nb;
#pragma unroll
    for (int i = 0; i < 32; ++i) { const int kk = 2 * i + (lane >> 5); scr[kk * 33 + (lane & 31)] = W[(size_t)(k0 + kk) * ldw + n0 + (lane & 31)]; }
    LDS_WAIT(); asm volatile("" ::: "memory");
    const int c = lane & 7;
#pragma unroll
    for (int j = 0; j < 4; ++j) { const int n = (lane >> 3) + 8 * j; const LAS float* s = scr + (8 * c) * 33 + n;
        u32x4 o; o.x = pk2(s[0 * 33], s[1 * 33]); o.y = pk2(s[2 * 33], s[3 * 33]); o.z = pk2(s[4 * 33], s[5 * 33]); o.w = pk2(s[6 * 33], s[7 * 33]);
        const int nr = glu ? glu_rowmap(n0 + n) : (n0 + n);
        *(u32x4*)(WT + (size_t)nr * K + k0 + 8 * c) = o; }
    LDS_WAIT(); asm volatile("" ::: "memory");
}
__device__ __forceinline__ void ln_row(const float* xrow, const float* g, const float* b, float* o32, bf16* o16, int lane, float pre_scale, const f32x4* addv, unsigned char* o8 = nullptr, unsigned char* o4 = nullptr) {
    f32x4 v[8]; float s = 0.f;
#pragma unroll
    for (int j = 0; j < 4; ++j) { const f32x4* p = (const f32x4*)(xrow + 8 * lane + 512 * j); v[2 * j] = p[0]; v[2 * j + 1] = p[1]; }
#pragma unroll
    for (int j = 0; j < 8; ++j) { v[j] = v[j] * pre_scale; if (addv) v[j] += addv[j]; s += (v[j][0] + v[j][1]) + (v[j][2] + v[j][3]); }
    const float mean = wave_sum(s, lane) * (1.f / D); float s2 = 0.f;
#pragma unroll
    for (int j = 0; j < 8; ++j) { v[j] = v[j] - mean; s2 += (v[j][0] * v[j][0] + v[j][1] * v[j][1]) + (v[j][2] * v[j][2] + v[j][3] * v[j][3]); }
    const float rstd = 1.f / sqrtf(wave_sum(s2, lane) * (1.f / D) + LN_EPS);
#pragma unroll
    for (int j = 0; j < 4; ++j) { const int c = 8 * lane + 512 * j; const f32x4 g0 = *(const f32x4*)(g + c), g1 = *(const f32x4*)(g + c + 4), b0 = *(const f32x4*)(b + c), b1 = *(const f32x4*)(b + c + 4);
        const f32x4 y0 = v[2 * j] * rstd * g0 + b0, y1 = v[2 * j + 1] * rstd * g1 + b1;
        if (o32) { *(f32x4*)(o32 + c) = y0; *(f32x4*)(o32 + c + 4) = y1; }
        if (o16) *(u32x4*)(o16 + c) = pack8(y0, y1);
        if (o8) { u32x2 q8; q8.x = pk_fp8x4(y0[0] * FP8_SA, y0[1] * FP8_SA, y0[2] * FP8_SA, y0[3] * FP8_SA); q8.y = pk_fp8x4(y1[0] * FP8_SA, y1[1] * FP8_SA, y1[2] * FP8_SA, y1[3] * FP8_SA); *(u32x2*)(o8 + c) = q8; }
        if (o4) *(unsigned*)(o4 + (c >> 1)) = pk_fp4x8(y0, y1, FP4_SA); }
}

__device__ __forceinline__ void ssm_tables(Frame& F, const Args& a, int l, int g) {
    LAS f32x2* Pw = (LAS f32x2*)(F.lds);
    LAS f32x2* bb = (LAS f32x2*)(F.lds + 33 * 64 * 8);
    LAS f32x2* Cc = (LAS f32x2*)(F.lds + 33 * 64 * 8 + 8192);
    LAS float* Mt = (LAS float*)(F.lds + 33 * 64 * 8 + 16384);
    const int tid = F.tid, lg = l * 32 + g;
    const float* lre = a.in[6] + lg * 64; const float* lim = a.in[7] + lg * 64; const float ldt = a.in[8][lg];
    const float* bre = a.in[9] + (size_t)lg * 1024; const float* bim = a.in[10] + (size_t)lg * 1024;
    const float* cre = a.in[11] + (size_t)lg * 1024; const float* cim = a.in[12] + (size_t)lg * 1024;
    const float* dsk = a.in[13] + lg * 16;
    const float dt = expf(ldt);
    if (tid < 64) {
        const int p = tid; const float ar = lre[p] * dt, th = lim[p] * dt;
        for (int d = 0; d <= 32; ++d) { const float mag = expf(ar * (float)d); float sn, cs; sincosf(th * (float)d, &sn, &cs); Pw[d * 64 + p] = (f32x2){mag * cs, mag * sn}; }
    }
    __syncthreads();
    for (int i = tid; i < 1024; i += NTHR) {
        const int p = i >> 4, h = i & 15; const f32x2 lb = Pw[64 + p]; const float lr = lre[p], li = lim[p];
        const float nr = lb[0] - 1.f, ni = lb[1], den = lr * lr + li * li; const float fr = (nr * lr + ni * li) / den, fi = (ni * lr - nr * li) / den;
        const float br = bre[p * 16 + h], bi = bim[p * 16 + h]; bb[p * 16 + h] = (f32x2){fr * br - fi * bi, fr * bi + fi * br};
        const int h2 = i >> 6, p2 = i & 63; Cc[h2 * 64 + p2] = (f32x2){cre[h2 * 64 + p2], cim[h2 * 64 + p2]};
    }
    __syncthreads();
    { const int d = tid >> 4, ho = tid & 15; float accm[16];
#pragma unroll
      for (int hi = 0; hi < 16; ++hi) accm[hi] = 0.f;
      for (int p = 0; p < 64; ++p) { const f32x2 c = Cc[ho * 64 + p], w = Pw[d * 64 + p]; const float cr = c[0] * w[0] - c[1] * w[1], ci = c[0] * w[1] + c[1] * w[0];
#pragma unroll
          for (int hi = 0; hi < 16; ++hi) { const f32x2 b = bb[p * 16 + hi]; accm[hi] += cr * b[0] - ci * b[1]; } }
      if (d == 0) accm[ho] += dsk[ho];
#pragma unroll
      for (int hi = 0; hi < 16; ++hi) Mt[(d * 16 + ho) * 16 + hi] = accm[hi]; }
    __syncthreads();
    bf16* W1 = (bf16*)(F.ws + WS_W1S) + (size_t)lg * 512 * UK;
    for (int ch = tid; ch < 512 * (UK / 8); ch += NTHR) {
        const int n = ch / (UK / 8), k = (ch % (UK / 8)) * 8, t = n >> 4, ho = n & 15; float v[8];
        if (k < 512) { const int j = k >> 4, hi0 = k & 15;
#pragma unroll
            for (int i = 0; i < 8; ++i) v[i] = (t >= j) ? Mt[((t - j) * 16 + ho) * 16 + hi0 + i] : 0.f; }
        else { const int pp = k - 512; const bool im = pp >= 64; const int p0 = pp & 63;
#pragma unroll
            for (int i = 0; i < 8; ++i) { const f32x2 c = Cc[ho * 64 + p0 + i], w = Pw[(t + 1) * 64 + p0 + i]; v[i] = im ? -(c[0] * w[1] + c[1] * w[0]) : (c[0] * w[0] - c[1] * w[1]); } }
        u32x4 o; o.x = pk2(v[0], v[1]); o.y = pk2(v[2], v[3]); o.z = pk2(v[4], v[5]); o.w = pk2(v[6], v[7]);
        *(u32x4*)(W1 + (size_t)n * UK + k) = o;
    }
    bf16* Wst = (bf16*)(F.ws + WS_WST) + (size_t)lg * 256 * 512;
    for (int ch = tid; ch < 256 * 64; ch += NTHR) {
        const int n = ch >> 6, k = (ch & 63) * 8, j = k >> 4, hi0 = k & 15; float v[8];
        if (n < 128) { const int p = n & 63; const bool im = n >= 64; const f32x2 w = Pw[(31 - j) * 64 + p];
#pragma unroll
            for (int i = 0; i < 8; ++i) { const f32x2 b = bb[p * 16 + hi0 + i]; v[i] = im ? (w[0] * b[1] + w[1] * b[0]) : (w[0] * b[0] - w[1] * b[1]); } }
        else {
#pragma unroll
            for (int i = 0; i < 8; ++i) v[i] = 0.f; }
        u32x4 o; o.x = pk2(v[0], v[1]); o.y = pk2(v[2], v[3]); o.z = pk2(v[4], v[5]); o.w = pk2(v[6], v[7]);
        *(u32x4*)(Wst + (size_t)n * 512 + k) = o;
    }
    if (tid < 64) ((f32x2*)(F.ws + WS_LAM))[lg * 64 + tid] = Pw[32 * 64 + tid];
    __syncthreads();
}

struct TItem { const float* W; unsigned char* WT; int K, ldw, fp4; };
constexpr int TI_INA = (D / 128) * (2304 / 32), TI_ING = (D / 128) * (6144 / 32), TI_IN = TI_INA + TI_ING, TI_MKV = (D / 128) * (1024 / 32), TI_SQ = (D / 128) * (D / 32), TI_DN = (DFF / 128) * (D / 32);
__host__ __device__ constexpr int t_count(int grp) { return grp == 0 ? TI_INA + 2 * TI_MKV + 2 * TI_SQ : (grp == 1 ? 32 * TI_SQ : (grp == 2 ? 32 * TI_DN + TI_INA + 2 * TI_SQ + 32 * TI_SQ + 32 * TI_DN : 2 * TI_ING)); }
__device__ __forceinline__ TItem t_decode(const Args& a, unsigned char* ws, int grp, int it) {
    const float* W; unsigned char* WT; int K, N, ldw, r, fp4 = 0;
#define T_CLS(cnt_, ipm_, src_, dst_, K_, N_, ld_, bt0_) if (it < (cnt_)) { const int bt = it / (ipm_) + (bt0_); r = it % (ipm_); K = (K_); N = (N_); ldw = (ld_); W = (src_) + (size_t)bt * K * ldw; WT = ws + (dst_) + (size_t)bt * N * K; goto t_done; } it -= (cnt_);
    if (grp == 3) { const int bt = it / TI_ING; r = it % TI_ING; K = D; N = 6144; ldw = INW; W = a.in[4] + (size_t)bt * D * INW + 2304; WT = ws + WS_WIN4 + (size_t)bt * 6144 * (D / 2); fp4 = 1; goto t_done; }
    if (grp == 0) {
        if (it < TI_INA) { r = it; K = D; N = 2304; ldw = INW; W = a.in[4]; WT = ws + WS_WIN; goto t_done; } it -= TI_INA;
        T_CLS(2 * TI_MKV, TI_MKV, a.in[15], WS_WMKV, D, 1024, 1024, 0)
        T_CLS(TI_SQ, TI_SQ, a.in[16], WS_WBR, D, D, D, 0)
        T_CLS(TI_SQ, TI_SQ, a.in[17], WS_WOUT, D, D, D, 0)
    } else if (grp == 1) {
        T_CLS(32 * TI_SQ, TI_SQ, a.in[22], WS_WUP, D, D, D, 0)
    } else {
        T_CLS(32 * TI_DN, TI_DN, a.in[24], WS_WDN, DFF, D, D, 0)
        if (it < TI_INA) { r = it; K = D; N = 2304; ldw = INW; W = a.in[4] + (size_t)D * INW; WT = ws + WS_WIN + (size_t)INW * D; goto t_done; } it -= TI_INA;
        T_CLS(TI_SQ, TI_SQ, a.in[16], WS_WBR, D, D, D, 1)
        T_CLS(TI_SQ, TI_SQ, a.in[17], WS_WOUT, D, D, D, 1)
        T_CLS(32 * TI_SQ, TI_SQ, a.in[22], WS_WUP, D, D, D, 32)
        T_CLS(32 * TI_DN, TI_DN, a.in[24], WS_WDN, DFF, D, D, 32)
    }
    W = a.in[4]; WT = ws + WS_WIN; K = D; N = INW; ldw = INW; r = 0;
t_done:
#undef T_CLS
    const int nblk = N / 32, kb = r / nblk, nb = r % nblk;
    TItem t; t.W = W + (size_t)(128 * kb) * ldw + 32 * nb; t.fp4 = fp4; t.K = fp4 ? K / 2 : K; t.WT = WT + (size_t)(32 * nb) * t.K + (fp4 ? 64 * kb : 128 * kb); t.ldw = ldw; return t;
}
template <bool NT> __device__ __forceinline__ void t_load(const TItem& t, float (&v)[64], int lane) {
    int ld = t.ldw; asm volatile("" : "+s"(ld));
    const float* p = t.W + (size_t)(lane >> 5) * ld + (lane & 31);
#pragma unroll
    for (int i = 0; i < 64; ++i) v[i] = NT ? __builtin_nontemporal_load(p + (size_t)(2 * i) * ld) : p[(size_t)(2 * i) * ld];
}
template <bool NTS = false, bool F4 = false> __device__ __forceinline__ void t_finish(const TItem& t, const float (&v)[64], LAS float* scr, int lane) {
#pragma unroll
    for (int i = 0; i < 64; ++i) { const int kk = 2 * i + (lane >> 5); scr[kk * 32 + (((lane & 31) + 2 * (kk >> 3)) & 31)] = v[i]; }
    LDS_WAIT(); asm volatile("" ::: "memory");
    const int c = lane & 15;
#pragma unroll
    for (int j = 0; j < 8; ++j) { const int n = (lane >> 4) + 4 * j; const LAS float* sp = scr + (8 * c) * 32 + ((n + 2 * c) & 31);
        if constexpr (F4) { const unsigned o4 = pk_fp4x8((f32x4){sp[0], sp[32], sp[64], sp[96]}, (f32x4){sp[128], sp[160], sp[192], sp[224]}, FP4_SW);
            if (NTS) __builtin_nontemporal_store(o4, (unsigned*)(t.WT + (size_t)n * t.K + 4 * c)); else *(unsigned*)(t.WT + (size_t)n * t.K + 4 * c) = o4; continue; }
        u32x2 o; o.x = pk_fp8x4(sp[0] * FP8_SW, sp[32] * FP8_SW, sp[64] * FP8_SW, sp[96] * FP8_SW); o.y = pk_fp8x4(sp[128] * FP8_SW, sp[160] * FP8_SW, sp[192] * FP8_SW, sp[224] * FP8_SW);
        if (NTS) __builtin_nontemporal_store(o, (u32x2*)(t.WT + (size_t)n * t.K + 8 * c)); else *(u32x2*)(t.WT + (size_t)n * t.K + 8 * c) = o; }
    LDS_WAIT(); asm volatile("" ::: "memory");
}
template <bool NT, bool F4 = false> __device__ __forceinline__ void t_run(Frame& F, const Args& a, int grp, int gw, int NGW, int n1 = 1 << 30, int w2 = -1, int NW2 = 1) {
    int lane = F.lane; asm volatile("" : "+s"(gw)); asm volatile("" : "+v"(lane));
    LAS float* scr = (LAS float*)(F.lds + F.wave * 16384); const int n = t_count(grp); if (n1 > n) n1 = n;
#define T_NEXT(i) (((i) < n1) ? (((i) + NGW < n1) ? (i) + NGW : ((w2 >= 0) ? n1 + w2 : n)) : (i) + NW2)
    float va[64], vb[64]; int it = (gw < n1) ? gw : ((w2 >= 0) ? n1 + w2 : n); TItem cur, nxt;
    if (it < n) { cur = t_decode(a, F.ws, grp, it); t_load<NT>(cur, va, lane); }
    while (it < n) {
        const int nit = T_NEXT(it); const bool hn = nit < n;
        if (hn) { nxt = t_decode(a, F.ws, grp, nit); t_load<NT>(nxt, vb, lane); }
        t_finish<NT, F4>(cur, va, scr, lane);
        if (hn) { cur = nxt;
#pragma unroll
            for (int i = 0; i < 64; ++i) va[i] = vb[i]; }
        it = nit; }
#undef T_NEXT
}
__device__ __forceinline__ void p0_prologue(Frame& F, const Args& a) {
    if (blockIdx.x < 64) ssm_tables(F, a, blockIdx.x >> 5, blockIdx.x & 31);
    LAS float* scr = (LAS float*)(F.lds + F.wave * 16384);
    const int gw = F.vcu * NWAVES + F.wave, NGW = F.G * NWAVES;
    t_run<false>(F, a, 0, gw, NGW);
    t_run<false, true>(F, a, 3, gw, NGW);
    { const int nbusy = (F.G > 64) ? 64 : 0, NW2 = (F.G - nbusy) * NWAVES, w2 = ((int)blockIdx.x >= nbusy) ? ((int)blockIdx.x - nbusy) * NWAVES + F.wave : -1;
      const int n1 = nbusy ? t_count(1) - 5 * NW2 : t_count(1);
      t_run<false>(F, a, 1, gw, NGW, n1 > 0 ? n1 : t_count(1), w2, NW2); }
    { constexpr int I_GLU = (512 / 64) * (1024 / 32);
      for (int it = gw; it < 2 * I_GLU; it += NGW) { const int bt = it / I_GLU, r = it % I_GLU; p0_transpose_item(a.in[14] + (size_t)bt * 512 * 1024, 512, 1024, 1024, (bf16*)(F.ws + WS_WGLU) + (size_t)bt * 1024 * 512, 1, scr, r, F.lane); } }
    for (int m = gw; m < T; m += NGW) ln_row(a.in[0] + (size_t)m * D, a.in[2], a.in[3], nullptr, (bf16*)(F.ws + WS_HB) + (size_t)m * D, F.lane, 1.f, nullptr, (unsigned char*)(F.ws + WS_H8) + (size_t)m * D, (unsigned char*)(F.ws + WS_H4) + (size_t)m * (D / 2));
    { const size_t n8 = (size_t)4096 * D / 8; const f32x4* src = (const f32x4*)a.in[1]; u32x2* dst = (u32x2*)(F.ws + WS_MEMB);
      for (size_t i = (size_t)blockIdx.x * NTHR + F.tid; i < n8; i += (size_t)F.G * NTHR) { const f32x4 x0 = src[2 * i] * FP8_SA, x1 = src[2 * i + 1] * FP8_SA; u32x2 q8; q8.x = pk_fp8x4(x0[0], x0[1], x0[2], x0[3]); q8.y = pk_fp8x4(x1[0], x1[1], x1[2], x1[3]); dst[i] = q8; } }
    { bf16* wr = (bf16*)(F.ws + WS_WRT);
      for (int i = blockIdx.x * NTHR + F.tid; i < NL * NE * D; i += F.G * NTHR) { const int l = i / (NE * D), r = i % (NE * D), e = r / D, k = r % D;
          const float w = a.in[20][(size_t)l * D * NE + (size_t)k * NE + e]; const unsigned hi = pk2(w, 0.f) & 0xffffu; const float lo = w - bf2f((unsigned short)hi);
          wr[((size_t)(l * 2 + 0) * NE + e) * D + k] = (bf16)hi; wr[((size_t)(l * 2 + 1) * NE + e) * D + k] = (bf16)(pk2(lo, 0.f) & 0xffffu); } }
}

#define EPI_ARGS const f32x4 (&acc)[2][2][4][2], const GUnit& u, int wr, int wc, int fr, int fq, const HOIST& hoist
#define EPI_ROWS(...) _Pragma("unroll") for (int ai = 0; ai < 2; ++ai) _Pragma("unroll") for (int m = 0; m < 4; ++m) { const int lrow = ai * 128 + wr * 64 + m * 16 + fr, lcol = wc * 64 + fq * 16; \
        const f32x4 v0 = acc[ai][0][m][0], v1 = acc[ai][0][m][1], v2 = acc[ai][1][m][0], v3 = acc[ai][1][m][1]; __VA_ARGS__ }
__device__ __forceinline__ u32x4 pk_fp8x16(const f32x4 a, const f32x4 b, const f32x4 c, const f32x4 d, float sc) {
    u32x4 w; w.x = pk_fp8x4(a[0] * sc, a[1] * sc, a[2] * sc, a[3] * sc); w.y = pk_fp8x4(b[0] * sc, b[1] * sc, b[2] * sc, b[3] * sc); w.z = pk_fp8x4(c[0] * sc, c[1] * sc, c[2] * sc, c[3] * sc); w.w = pk_fp8x4(d[0] * sc, d[1] * sc, d[2] * sc, d[3] * sc); return w; }

__device__ __forceinline__ unsigned gate_u8x4(const f32x4 x, const float sc = FP8_DESCALE) { unsigned w = 0u;
    const float k = -sc * 1.4426950408889634f;
    const f32x2 t0 = (f32x2){x[0], x[1]} * k, t1 = (f32x2){x[2], x[3]} * k;
    const f32x2 e0 = (f32x2){__builtin_amdgcn_exp2f(t0[0]), __builtin_amdgcn_exp2f(t0[1])} + 1.0f, e1 = (f32x2){__builtin_amdgcn_exp2f(t1[0]), __builtin_amdgcn_exp2f(t1[1])} + 1.0f;
    const f32x2 q0 = (f32x2){__builtin_amdgcn_rcpf(e0[0]), __builtin_amdgcn_rcpf(e0[1])} * 256.0f - 0.5f, q1 = (f32x2){__builtin_amdgcn_rcpf(e1[0]), __builtin_amdgcn_rcpf(e1[1])} * 256.0f - 0.5f;
    w = __builtin_amdgcn_cvt_pk_u8_f32(q0[0], 0, w); w = __builtin_amdgcn_cvt_pk_u8_f32(q0[1], 1, w); w = __builtin_amdgcn_cvt_pk_u8_f32(q1[0], 2, w); w = __builtin_amdgcn_cvt_pk_u8_f32(q1[1], 3, w); return w; }
struct PInproj {
    static constexpr bool GATHER = false, FP8 = true, FP4 = false; static constexpr int RELAX = 0; unsigned lda, ldb; int probe_ = 0;
    const char *hb, *win, *memb, *wmkv; int G, c, nextra, mode, i0, i1;
    bf16 *q, *kv, *U, *qm, *mkv; unsigned char* gates;
    __device__ __forceinline__ bool next(int i, GUnit& u) const {
        if (i + i0 >= i1) return false;
        long L = (long)(i + i0) * G + c; int pm, pn;
        if (mode) { if (L >= 128 * 24) return false; pg8::tile_map((int)L, 128, 24, pm, pn); pn += 9; u.A = hb + (size_t)pm * 256 * 2048; u.B = win + (size_t)pn * 256 * 2048; u.nt = 16; u.keep = 0; u.pm = pm; u.pn = pn; u.aux = 0; return true; }
        if (L < 128 * 9) { pg8::tile_map((int)L, 128, 9, pm, pn); u.A = hb + (size_t)pm * 256 * 2048; u.B = win + (size_t)pn * 256 * 2048; u.nt = 16; u.keep = 0; u.pm = pm; u.pn = pn; u.aux = 0; return true; }
        L -= 128 * 9; if (L >= nextra) return false;
        pm = (int)L & 15; pn = (int)L >> 4; u.A = memb + (size_t)pm * 256 * 2048; u.B = wmkv + (size_t)pn * 256 * 2048; u.nt = 16; u.keep = 0; u.pm = pm; u.pn = pn; u.aux = 1; return true;
    }
    template <class HOIST> __device__ __forceinline__ void epi(EPI_ARGS) const {
        const int pn = u.pn, row0 = u.pm * 256, col0 = pn * 256;
        if (PROBE_VARIANT >= 3 && probe_) return;
#define ST_BF16x16(ptr, sc) do { bf16* p_ = (ptr); *(u32x4*)p_ = pack8(v0 * (sc), v1 * (sc)); *(u32x4*)(p_ + 8) = pack8(v2 * (sc), v3 * (sc)); } while (0)
        if (u.aux) { EPI_ROWS( ST_BF16x16(mkv + (size_t)(row0 + lrow) * 2048 + col0 + lcol, FP8_DESCALE); ) }
        else if (pn < 4) { EPI_ROWS( ST_BF16x16(q + (size_t)(row0 + lrow) * 1024 + col0 + lcol, 0.125f * 1.4426950408889634f * FP8_DESCALE); ) }
        else if (pn == 4) { EPI_ROWS( ST_BF16x16(kv + (size_t)(row0 + lrow) * 256 + lcol, FP8_DESCALE); ) }
        else if (pn < 7) { EPI_ROWS( const int ch = col0 - 1280 + lcol, g = ch >> 4, row = row0 + lrow, b = row >> 11, sq = row & 2047;
                                     ST_BF16x16(U + ((size_t)(g * 1024 + b * 64 + (sq >> 5))) * UK + (sq & 31) * 16, FP8_DESCALE); ) }
        else if (pn < 9) { EPI_ROWS( ST_BF16x16(qm + (size_t)(row0 + lrow) * 512 + col0 - 1792 + lcol, 0.08838834764831845f * 1.4426950408889634f * FP8_DESCALE); ) }
        else { EPI_ROWS( u32x4 w; w.x = gate_u8x4(v0); w.y = gate_u8x4(v1); w.z = gate_u8x4(v2); w.w = gate_u8x4(v3); *(u32x4*)(gates + (size_t)(row0 + lrow) * 6144 + col0 - 2304 + lcol) = w; ) }
    }
};

struct PInGate4 {
    static constexpr bool GATHER = false, FP8 = false, FP4 = true; static constexpr int RELAX = 0; unsigned lda, ldb; int probe_ = 0;
    const char *h4, *win4; int G, c; unsigned char* gates;
    __device__ __forceinline__ bool next(int i, GUnit& u) const {
        const long L = (long)i * G + c; if (L >= 128 * 24) return false; int pm, pn; pg8::tile_map((int)L, 128, 24, pm, pn);
        u.A = h4 + (size_t)pm * 256 * 1024; u.B = win4 + (size_t)pn * 256 * 1024; u.nt = 8; u.keep = 0; u.pm = pm; u.pn = pn; u.aux = 0; return true;
    }
    template <class HOIST> __device__ __forceinline__ void epi(EPI_ARGS) const {
        EPI_ROWS( u32x4 w; w.x = gate_u8x4(v0, FP4_DESCALE); w.y = gate_u8x4(v1, FP4_DESCALE); w.z = gate_u8x4(v2, FP4_DESCALE); w.w = gate_u8x4(v3, FP4_DESCALE);
                  *(u32x4*)(gates + (size_t)(u.pm * 256 + lrow) * 6144 + u.pn * 256 + lcol) = w; )
    }
};

struct PSsmState {
    static constexpr bool GATHER = false, FP8 = false, FP4 = false; static constexpr int RELAX = 0; unsigned lda, ldb; int probe_ = 0;
    const char *U, *Wst; int G, c; float* S;
    __device__ __forceinline__ bool next(int i, GUnit& u) const {
        const long L = (long)i * G + c; if (L >= 128) return false;
        const int g = (int)L >> 2, rt = (int)L & 3; u.A = U + ((size_t)g * 1024 + rt * 256) * (UK * 2); u.B = Wst + (size_t)g * 256 * 1024; u.nt = 8; u.keep = 0; u.pm = rt; u.pn = 0; u.aux = g; return true;
    }
    template <class HOIST> __device__ __forceinline__ void epi(EPI_ARGS) const {
        float* base = S + ((size_t)u.aux * 1024 + u.pm * 256) * 128;
        EPI_ROWS( if (wc < 2) { float* p = base + (size_t)lrow * 128 + lcol; *(f32x4*)p = v0; *(f32x4*)(p + 4) = v1; *(f32x4*)(p + 8) = v2; *(f32x4*)(p + 12) = v3; } )
    }
};

__device__ __forceinline__ float gelu_tanh(float x) { const float u2 = 1.5957691216057308f * (x + 0.044715f * x * x * x); return x * __builtin_amdgcn_rcpf(1.0f + __expf(-u2)); }
struct PSsmOut {
    static constexpr bool GATHER = false, FP8 = false, FP4 = false; static constexpr int RELAX = 0; unsigned lda, ldb; int probe_ = 0;
    const char *U, *W1; int G, c; bf16* z;
    __device__ __forceinline__ bool next(int i, GUnit& u) const {
        if (c >= 128 || i >= 2) return false;
        const int g = c >> 2, rt = c & 3, pn = i; u.A = U + ((size_t)g * 1024 + rt * 256) * (UK * 2); u.B = W1 + ((size_t)g * 512 + pn * 256) * (UK * 2); u.nt = 10; u.keep = 0; u.pm = rt; u.pn = pn; u.aux = g; return true;
    }
    template <class HOIST> __device__ __forceinline__ void epi(EPI_ARGS) const {
        const int g = u.aux;
        EPI_ROWS( const int row = u.pm * 256 + lrow, b = row >> 6, cc = row & 63, col = u.pn * 256 + lcol, t = col >> 4; f32x4 y0, y1, y2, y3;
                  _Pragma("unroll") for (int j = 0; j < 4; ++j) { y0[j] = gelu_tanh(v0[j]); y1[j] = gelu_tanh(v1[j]); y2[j] = gelu_tanh(v2[j]); y3[j] = gelu_tanh(v3[j]); }
                  bf16* zp = z + (size_t)(b * 2048 + cc * 32 + t) * 512 + g * 16; *(u32x4*)zp = pack8(y0, y1); *(u32x4*)(zp + 8) = pack8(y2, y3); )
    }
};

struct PGlu {
    static constexpr bool GATHER = false, FP8 = false, FP4 = false; static constexpr int RELAX = 0; unsigned lda, ldb; int probe_ = 0;
    const char *z, *wg; int G, c; unsigned char* mix;
    __device__ __forceinline__ bool next(int i, GUnit& u) const {
        const long L = (long)i * G + c; if (L >= 128 * 4) return false; int pm, pn; pg8::tile_map((int)L, 128, 4, pm, pn);
        u.A = z + (size_t)pm * 256 * 1024; u.B = wg + (size_t)pn * 256 * 1024; u.nt = 8; u.keep = 0; u.pm = pm; u.pn = pn; u.aux = 0; return true;
    }
    template <class HOIST> __device__ __forceinline__ void epi(EPI_ARGS) const {
        EPI_ROWS( const int o = 128 * u.pn + 32 * wc + 8 * fq; u32x2 w;
                  w.x = pk_fp8x4(v0[0] * fsigmoid(v2[0]) * FP8_SA, v0[1] * fsigmoid(v2[1]) * FP8_SA, v0[2] * fsigmoid(v2[2]) * FP8_SA, v0[3] * fsigmoid(v2[3]) * FP8_SA);
                  w.y = pk_fp8x4(v1[0] * fsigmoid(v3[0]) * FP8_SA, v1[1] * fsigmoid(v3[1]) * FP8_SA, v1[2] * fsigmoid(v3[2]) * FP8_SA, v1[3] * fsigmoid(v3[3]) * FP8_SA);
                  *(u32x2*)(mix + (size_t)(u.pm * 256 + lrow) * 2048 + 1024 + o) = w; (void)lcol; )
    }
};

__device__ __forceinline__ float ubf(unsigned w, int k) { return (float)((w >> (8 * k)) & 0xffu); }
struct PBranch {
    static constexpr bool GATHER = false, FP8 = true, FP4 = false; static constexpr int RELAX = 1; unsigned lda, ldb; int probe_ = 0;
    const char *mix, *wb; int G, c; const unsigned char* gates; unsigned char* mrg;
    __device__ __forceinline__ bool next(int i, GUnit& u) const {
        const int tile = (i / 3) * G + c, seg = i % 3; if (tile >= 128 * 8) return false; int pm, pn; pg8::tile_map(tile, 128, 8, pm, pn);
        const int koff = seg == 0 ? 0 : (seg == 1 ? 1024 : 1536);
        u.A = mix + (size_t)pm * 256 * 2048 + koff; u.B = wb + (size_t)pn * 256 * 2048 + koff; u.nt = seg == 0 ? 8 : 4; u.keep = seg != 0; u.pm = pm; u.pn = pn; u.aux = seg; return true;
    }
    template <class HOIST> __device__ __forceinline__ void epi(f32x4 (&acc)[2][2][4][2], const GUnit& u, int wr, int wc, int fr, int fq, const HOIST& hoist) const {
        const int seg = u.aux; const int so = seg < 2 ? seg * 2048 : 4096; hoist();
#pragma unroll
        for (int ai = 0; ai < 2; ++ai) {
            u32x4 ga[4], gb[4];
#pragma unroll
            for (int m = 0; m < 4; ++m) { const unsigned char* gp = gates + (size_t)(u.pm * 256 + ai * 128 + wr * 64 + m * 16 + fr) * 6144 + u.pn * 256 + wc * 64 + fq * 16 + so;
                ga[m] = *(const u32x4*)gp; gb[m] = (seg < 2) ? *(const u32x4*)(gp + 2048) : (u32x4){0u, 0u, 0u, 0u}; }
#pragma unroll
            for (int m = 0; m < 4; ++m) { const int row = u.pm * 256 + ai * 128 + wr * 64 + m * 16 + fr, col = u.pn * 256 + wc * 64 + fq * 16;
                if (seg < 2) {
#pragma unroll
                    for (int w4 = 0; w4 < 4; ++w4) { const unsigned a = ga[m][w4], b = gb[m][w4]; f32x4 r;
                        r[0] = (ubf(a, 0) + 0.5f) * __builtin_amdgcn_rcpf(ubf(b, 0) + 0.5f); r[1] = (ubf(a, 1) + 0.5f) * __builtin_amdgcn_rcpf(ubf(b, 1) + 0.5f);
                        r[2] = (ubf(a, 2) + 0.5f) * __builtin_amdgcn_rcpf(ubf(b, 2) + 0.5f); r[3] = (ubf(a, 3) + 0.5f) * __builtin_amdgcn_rcpf(ubf(b, 3) + 0.5f);
                        acc[ai][w4 >> 1][m][w4 & 1] *= r; } }
                else { f32x4 o[4];
#pragma unroll
                    for (int w4 = 0; w4 < 4; ++w4) { const unsigned a = ga[m][w4]; f32x4 r;
                        r[0] = ubf(a, 0) + 0.5f; r[1] = ubf(a, 1) + 0.5f; r[2] = ubf(a, 2) + 0.5f; r[3] = ubf(a, 3) + 0.5f;
                        o[w4] = acc[ai][w4 >> 1][m][w4 & 1] * r; }
                    *(u32x4*)(mrg + (size_t)row * 2048 + col) = pk_fp8x16(o[0], o[1], o[2], o[3], FP8_DESCALE * FP8_SA / 256.0f); } }
            asm volatile("" ::: "memory");
        }
    }
};

struct PWout {
    static constexpr bool GATHER = false, FP8 = true, FP4 = false; static constexpr int RELAX = 24; unsigned lda, ldb; int probe_ = 0;
    const char *mrg, *wo; int G, c; bf16* h;
    __device__ __forceinline__ bool next(int i, GUnit& u) const {
        const long L = (long)i * G + c; if (L >= 128 * 8) return false; int pm, pn; pg8::tile_map((int)L, 128, 8, pm, pn);
        u.A = mrg + (size_t)pm * 256 * 2048; u.B = wo + (size_t)pn * 256 * 2048; u.nt = 16; u.keep = 0; u.pm = pm; u.pn = pn; u.aux = 0; return true;
    }
    template <class HOIST> __device__ __forceinline__ void epi(EPI_ARGS) const {
        u32x4 hwv[2][4][2];
#pragma unroll
        for (int ai = 0; ai < 2; ++ai)
#pragma unroll
            for (int m = 0; m < 4; ++m) { const bf16* hp = h + (size_t)(u.pm * 256 + ai * 128 + wr * 64 + m * 16 + fr) * 2048 + u.pn * 256 + wc * 64 + fq * 16; hwv[ai][m][0] = *(const u32x4*)hp; hwv[ai][m][1] = *(const u32x4*)(hp + 8); }
        hoist();
        EPI_ROWS( bf16* p = h + (size_t)(u.pm * 256 + lrow) * 2048 + u.pn * 256 + lcol; const u32x4 ha = hwv[ai][m][0], hb2 = hwv[ai][m][1];
                  const f32x4 h0 = (f32x4){bflo(ha.x), bfhi(ha.x), bflo(ha.y), bfhi(ha.y)}, h1 = (f32x4){bflo(ha.z), bfhi(ha.z), bflo(ha.w), bfhi(ha.w)};
                  const f32x4 h2 = (f32x4){bflo(hb2.x), bfhi(hb2.x), bflo(hb2.y), bfhi(hb2.y)}, h3 = (f32x4){bflo(hb2.z), bfhi(hb2.z), bflo(hb2.w), bfhi(hb2.w)};
                  *(u32x4*)p = pack8(h0 * DN_ALPHA + v0 * FP8_DESCALE, h1 * DN_ALPHA + v1 * FP8_DESCALE); *(u32x4*)(p + 8) = pack8(h2 * DN_ALPHA + v2 * FP8_DESCALE, h3 * DN_ALPHA + v3 * FP8_DESCALE); )
    }
};

__device__ __forceinline__ void moe_tables(Frame& F, int l) {
    volatile LAS int* cnt = (volatile LAS int*)(F.lds + MISC_OFF + MO_CNT); volatile LAS int* tst = (volatile LAS int*)(F.lds + MISC_OFF + MO_TST);
    volatile LAS int* pnt = (volatile LAS int*)(F.lds + MISC_OFF + MO_NT); volatile LAS unsigned char* te = (volatile LAS unsigned char*)(F.lds + MISC_OFF + MO_TE);
    __syncthreads();
    if (F.tid < 32) cnt[F.tid] = (int)__hip_atomic_load(F.ctl + CW_CNT + (l * 32 + F.tid) * 64, RLX_AGENT);
    __syncthreads();
    if (F.tid == 0) { int s = 0; for (int e = 0; e < 32; ++e) { tst[e] = s; s += (cnt[e] + 255) >> 8; } tst[32] = s; pnt[0] = s; }
    __syncthreads();
    const int NT = pnt[0];
    for (int t = F.tid; t < NT; t += NTHR) { int e = 0; while (e < 31 && tst[e + 1] <= t) ++e; te[t] = (unsigned char)e; }
    __syncthreads();
}

struct PMoeUp {
    static constexpr bool GATHER = true, FP8 = true, FP4 = false; static constexpr int RELAX = 16; unsigned lda, ldb; int probe_ = 0;
    const char *hb, *wup; int G, c, i0, i1; const int* list; const float* bup; unsigned char* act; LAS unsigned char* misc;
    __device__ __forceinline__ bool next(int i, GUnit& u) const {
        if (i + i0 >= i1) return false;
        const int NT = __builtin_amdgcn_readfirstlane(*(volatile LAS int*)(misc + MO_NT)); const long L = (long)(i + i0) * G + c; if (L >= (long)NT * 8) return false; int pm, pn; pg8::tile_map((int)L, NT, 8, pm, pn);
        const int e = __builtin_amdgcn_readfirstlane((int)((volatile LAS unsigned char*)(misc + MO_TE))[pm]);
        u.A = hb; u.B = wup + ((size_t)e * 2048 + pn * 256) * 2048; u.nt = 16; u.keep = 0; u.pm = pm; u.pn = pn; u.aux = e; u.slot = i & 1; return true;
    }
    __device__ __forceinline__ void gather_issue(const GUnit& u, const int (&RA)[2], LAS unsigned* slot) const {
        const int e = u.aux, cnt = ((volatile LAS int*)(misc + MO_CNT))[e], base = (u.pm - ((volatile LAS int*)(misc + MO_TST))[e]) * 256;
#pragma unroll
        for (int i = 0; i < 2; ++i)
#pragma unroll
            for (int h = 0; h < 2; ++h) { int sl = base + h * 128 + RA[i]; sl = sl < cnt ? sl : cnt - 1;
                __builtin_amdgcn_global_load_lds((const unsigned*)(list + e * 32768 + sl), slot + (i * 2 + h) * 64, 4, 0, 0); }
    }
    __device__ __forceinline__ void bias_issue(const GUnit& u, int lane) const {
        __builtin_amdgcn_global_load_lds((const unsigned*)(bup + (size_t)u.aux * 2048 + u.pn * 256 + lane * 4), (LAS unsigned*)(misc + 4096 + u.slot * 1024), 16, 0, 0); }
    __device__ __forceinline__ void gather(const GUnit& u, const int (&RA)[2], const int (&CA)[2], unsigned (&g0)[2], unsigned (&g1)[2]) const {
        const int e = u.aux, cnt = ((volatile LAS int*)(misc + MO_CNT))[e], base = (u.pm - ((volatile LAS int*)(misc + MO_TST))[e]) * 256;
#pragma unroll
        for (int i = 0; i < 2; ++i) { const int s0 = base + RA[i], s1 = s0 + 128;
            const int t0 = s0 < cnt ? list[e * 32768 + s0] : 0, t1 = s1 < cnt ? list[e * 32768 + s1] : 0;
            g0[i] = (unsigned)t0 * 2048u + (unsigned)CA[i] * 2u; g1[i] = (unsigned)t1 * 2048u + (unsigned)CA[i] * 2u; }
    }
    template <class HOIST> __device__ __forceinline__ void epi(EPI_ARGS) const {
        f32x4 bv[4];
        if constexpr (RELAX == 2) { hoist(); const LAS float* bias = (const LAS float*)(misc + 4096 + u.slot * 1024) + wc * 64 + 16 * fq;
#pragma unroll
            for (int j = 0; j < 4; ++j) bv[j] = *(const LAS f32x4*)(bias + 4 * j); }
        else { const float* bias = bup + (size_t)u.aux * 2048 + u.pn * 256 + wc * 64 + 16 * fq;
#pragma unroll
            for (int j = 0; j < 4; ++j) bv[j] = *(const f32x4*)(bias + 4 * j);
            hoist(); }
        EPI_ROWS( const f32x4 x[4] = {v0 * FP8_DESCALE + bv[0], v1 * FP8_DESCALE + bv[1], v2 * FP8_DESCALE + bv[2], v3 * FP8_DESCALE + bv[3]}; f32x2 r[4];
                  _Pragma("unroll") for (int k = 0; k < 4; ++k) {
                      const f32x2 gl = (f32x2){fminf(x[k][0], 7.0f), fminf(x[k][2], 7.0f)}, ln = (f32x2){fminf(fmaxf(x[k][1], -7.0f), 7.0f), fminf(fmaxf(x[k][3], -7.0f), 7.0f)};
                      const f32x2 t = gl * (-1.702f * 1.4426950408889634f);
                      const f32x2 e = (f32x2){__builtin_amdgcn_exp2f(t[0]), __builtin_amdgcn_exp2f(t[1])} + 1.0f;
                      const f32x2 sg = (f32x2){__builtin_amdgcn_rcpf(e[0]), __builtin_amdgcn_rcpf(e[1])};
                      r[k] = (gl * sg) * (ln * FP8_SA + FP8_SA); }
                  u32x2 w; w.x = __builtin_amdgcn_cvt_pk_fp8_f32(r[0][0], r[0][1], 0u, false); w.x = __builtin_amdgcn_cvt_pk_fp8_f32(r[1][0], r[1][1], w.x, true);
                  w.y = __builtin_amdgcn_cvt_pk_fp8_f32(r[2][0], r[2][1], 0u, false); w.y = __builtin_amdgcn_cvt_pk_fp8_f32(r[3][0], r[3][1], w.y, true);
                  *(u32x2*)(act + (size_t)(u.pm * 256 + lrow) * 1024 + u.pn * 128 + (lcol >> 1)) = w; )
    }
};
struct PMoeDown {
    static constexpr bool GATHER = false, FP8 = true, FP4 = false; static constexpr int RELAX = 2; unsigned lda, ldb; int probe_ = 0;
    const char *act, *wdn; int G, c; const float* bdn; unsigned char* op; LAS unsigned char* misc;
    __device__ __forceinline__ bool next(int i, GUnit& u) const {
        const int NT = __builtin_amdgcn_readfirstlane(*(volatile LAS int*)(misc + MO_NT)); const long L = (long)i * G + c; if (L >= (long)NT * 8) return false; int pm, pn; pg8::tile_map((int)L, NT, 8, pm, pn);
        const int e = __builtin_amdgcn_readfirstlane((int)((volatile LAS unsigned char*)(misc + MO_TE))[pm]);
        u.A = act + (size_t)pm * 256 * 1024; u.B = wdn + ((size_t)e * 2048 + pn * 256) * 1024; u.nt = 8; u.keep = 0; u.pm = pm; u.pn = pn; u.aux = e; u.slot = i & 1; return true;
    }
    __device__ __forceinline__ void bias_issue(const GUnit& u, int lane) const {
        __builtin_amdgcn_global_load_lds((const unsigned*)(bdn + (size_t)u.aux * 2048 + u.pn * 256 + lane * 4), (LAS unsigned*)(misc + 4096 + u.slot * 1024), 16, 0, 0); }
    template <class HOIST> __device__ __forceinline__ void epi(EPI_ARGS) const {
        hoist();
        const LAS float* bias = (const LAS float*)(misc + 4096 + u.slot * 1024) + wc * 64 + 16 * fq; f32x4 bv[4];
#pragma unroll
        for (int j = 0; j < 4; ++j) bv[j] = *(const LAS f32x4*)(bias + 4 * j) * FP8_SO;
        EPI_ROWS( *(u32x4*)(op + (size_t)(u.pm * 256 + lrow) * 2048 + u.pn * 256 + lcol) = pk_fp8x16(v0 * (FP8_DESCALE * FP8_SO) + bv[0], v1 * (FP8_DESCALE * FP8_SO) + bv[1], v2 * (FP8_DESCALE * FP8_SO) + bv[2], v3 * (FP8_DESCALE * FP8_SO) + bv[3], 1.0f); )
    }
};

constexpr int SWA_KS = 144, SWA_VS = 528, SWA_VOFF = 256 * SWA_KS;
__device__ __forceinline__ void swa_unit(Frame& F, int unit, const bf16* q, const bf16* kv, const float* sinks, unsigned char* mix) {
    const int b = unit >> 5, nb = (unit >> 1) & 15, kvh = unit & 1, tok0 = b * 2048 + nb * 128, tid = F.tid, lane = F.lane, l15 = lane & 15, quad = lane >> 4;
    LAS unsigned char* Ks = F.lds; LAS unsigned char* Vt = F.lds + SWA_VOFF;
    __syncthreads();
    { u32x4 kr[4], va[2], vb[2];
#pragma unroll
      for (int i = 0; i < 4; ++i) { const int cid = tid + 512 * i, key = cid >> 3, c8 = cid & 7; const bool ok = (nb > 0) || (key >= 128);
          kr[i] = *(const u32x4*)(kv + (size_t)(tok0 + (ok ? key - 128 : 0)) * 256 + kvh * 64 + c8 * 8); }
#pragma unroll
      for (int i = 0; i < 2; ++i) { const int task = tid + 512 * i, kp = task >> 3, c8 = task & 7; const bool ok = (nb > 0) || (kp >= 64);
          const bf16* p = kv + (size_t)(tok0 + (ok ? 2 * kp - 128 : 0)) * 256 + 128 + kvh * 64 + c8 * 8; va[i] = *(const u32x4*)p; vb[i] = *(const u32x4*)(p + 256); }
#pragma unroll
      for (int i = 0; i < 4; ++i) { const int cid = tid + 512 * i, key = cid >> 3, c8 = cid & 7; const bool ok = (nb > 0) || (key >= 128);
          *(LAS u32x4*)(Ks + key * SWA_KS + c8 * 16) = ok ? kr[i] : (u32x4){0u, 0u, 0u, 0u}; }
#pragma unroll
      for (int i = 0; i < 2; ++i) { const int task = tid + 512 * i, kp = task >> 3, c8 = task & 7; const bool ok = (nb > 0) || (kp >= 64);
          const u32x4 a4 = ok ? va[i] : (u32x4){0u, 0u, 0u, 0u}, b4 = ok ? vb[i] : (u32x4){0u, 0u, 0u, 0u};
#pragma unroll
          for (int e = 0; e < 4; ++e) { const unsigned lo = (a4[e] & 0xffffu) | (b4[e] << 16), hi = (a4[e] >> 16) | (b4[e] & 0xffff0000u);
              *(LAS unsigned*)(Vt + (c8 * 8 + 2 * e) * SWA_VS + kp * 4) = lo; *(LAS unsigned*)(Vt + (c8 * 8 + 2 * e + 1) * SWA_VS + kp * 4) = hi; } } }
    __syncthreads();
    const int head = kvh * 8 + F.wave; const float sink = sinks[head] * 1.4426950408889634f;
    const bf16* qbase = q + (size_t)(tok0 + l15) * 1024 + head * 64 + quad * 8;
    bf16x8 nq0 = *(const bf16x8*)qbase, nq1 = *(const bf16x8*)(qbase + 32);
    const bool first = (nb == 0);
    for (int qg = 0; qg < 8; ++qg) {
        const int q0 = 16 * qg, tokq = tok0 + q0 + l15;
        const bf16x8 bq0 = nq0, bq1 = nq1;
        if (qg < 7) { const bf16* qp = qbase + (size_t)(16 * (qg + 1)) * 1024; nq0 = *(const bf16x8*)qp; nq1 = *(const bf16x8*)(qp + 32); }
        f32x4 s[10];
#pragma unroll
        for (int kt = 0; kt < 9; ++kt) { const LAS unsigned char* kp = Ks + (q0 + 16 * kt + l15) * SWA_KS + quad * 16;
            f32x4 a = (f32x4){0.f, 0.f, 0.f, 0.f};
            a = __builtin_amdgcn_mfma_f32_16x16x32_bf16(*(const LAS bf16x8*)kp, bq0, a, 0, 0, 0);
            a = __builtin_amdgcn_mfma_f32_16x16x32_bf16(*(const LAS bf16x8*)(kp + 64), bq1, a, 0, 0, 0); s[kt] = a; if (kt & 1) __builtin_amdgcn_sched_barrier(0); }
        s[9] = (f32x4){0.f, 0.f, 0.f, 0.f};
        float mx = sink;
#pragma unroll
        for (int v = 0; v < 4; ++v) { const int kk = 4 * quad + v; s[0][v] = (kk > l15) ? s[0][v] : -1e30f; s[8][v] = (kk <= l15) ? s[8][v] : -1e30f; }
        if (first) {
#pragma unroll
            for (int kt = 0; kt < 9; ++kt)
#pragma unroll
                for (int v = 0; v < 4; ++v) s[kt][v] = (q0 + 16 * kt + 4 * quad + v >= 128) ? s[kt][v] : -1e30f; }
#pragma unroll
        for (int kt = 0; kt < 9; ++kt)
#pragma unroll
            for (int v = 0; v < 4; ++v) mx = fmaxf(mx, s[kt][v]);
        mx = fmaxf(mx, shx(mx, 16, lane)); mx = fmaxf(mx, shx(mx, 32, lane));
        float sum = 0.f;
#pragma unroll
        for (int kt = 0; kt < 9; ++kt)
#pragma unroll
            for (int v = 0; v < 4; ++v) { const float e = __builtin_amdgcn_exp2f(s[kt][v] - mx); s[kt][v] = e; sum += e; }
        sum += shx(sum, 16, lane); sum += shx(sum, 32, lane);
        const float inv = 1.0f / (sum + __builtin_amdgcn_exp2f(sink - mx));
        bf16x8 pb[5];
#pragma unroll
        for (int i = 0; i < 5; ++i) pb[i] = __builtin_bit_cast(bf16x8, pack8(s[2 * i], s[2 * i + 1]));
        unsigned char* op = mix + (size_t)tokq * 2048 + head * 64 + 4 * quad;
#pragma unroll 1
        for (int dt = 0; dt < 4; ++dt) { f32x4 o = (f32x4){0.f, 0.f, 0.f, 0.f};
#pragma unroll
            for (int i = 0; i < 5; ++i) { const LAS unsigned char* vp = Vt + (16 * dt + l15) * SWA_VS + (q0 + 32 * i + 4 * quad) * 2;
                const u32x2 x0 = *(const LAS u32x2*)vp, x1 = (i < 4) ? *(const LAS u32x2*)(vp + 32) : x0;
                const u32x4 av = (u32x4){x0.x, x0.y, x1.x, x1.y};
                o = __builtin_amdgcn_mfma_f32_16x16x32_bf16(__builtin_bit_cast(bf16x8, av), pb[i], o, 0, 0, 0); }
            const float sc8 = inv * FP8_SA; *(unsigned*)(op + 16 * dt) = pk_fp8x4(o[0] * sc8, o[1] * sc8, o[2] * sc8, o[3] * sc8); }
    }
}

constexpr int MA_KS = 272, MA_VS = 528, MA_VOFF = 256 * MA_KS;
__device__ __forceinline__ void memattn_unit(Frame& F, int unit, int l, const bf16* qm, const bf16* mkv, unsigned char* mix) {
    const int b = unit >> 5, head = (unit >> 3) & 3, qc = unit & 7, tid = F.tid, lane = F.lane, l15 = lane & 15, quad = lane >> 4;
    LAS unsigned char* Ks = F.lds; LAS unsigned char* Vt = F.lds + MA_VOFF;
    const bf16* kbase = mkv + (size_t)(b * 256) * 2048 + l * 1024 + head * 128; const bf16* vbase = kbase + 512;
    __syncthreads();
#pragma unroll
    for (int i = 0; i < 8; ++i) { const int cid = tid + 512 * i, key = cid >> 4, c8 = cid & 15;
        *(LAS u32x4*)(Ks + key * MA_KS + c8 * 16) = *(const u32x4*)(kbase + (size_t)key * 2048 + c8 * 8); }
#pragma unroll
    for (int i = 0; i < 4; ++i) { const int task = tid + 512 * i, kp = task >> 4, c8 = task & 15;
        const bf16* p = vbase + (size_t)(2 * kp) * 2048 + c8 * 8; const u32x4 va = *(const u32x4*)p, vb = *(const u32x4*)(p + 2048);
#pragma unroll
        for (int e = 0; e < 4; ++e) { const unsigned lo = (va[e] & 0xffffu) | (vb[e] << 16), hi = (va[e] >> 16) | (vb[e] & 0xffff0000u);
            *(LAS unsigned*)(Vt + (c8 * 8 + 2 * e) * MA_VS + kp * 4) = lo; *(LAS unsigned*)(Vt + (c8 * 8 + 2 * e + 1) * MA_VS + kp * 4) = hi; } }
    __syncthreads();
    for (int gi = 0; gi < 2; ++gi) {
        const int tokq = b * 2048 + qc * 256 + F.wave * 32 + gi * 16 + l15;
        const bf16* qp = qm + (size_t)tokq * 512 + head * 128 + quad * 8;
        bf16x8 bq[4];
#pragma unroll
        for (int s4 = 0; s4 < 4; ++s4) bq[s4] = *(const bf16x8*)(qp + 32 * s4);
        f32x4 s[16];
#pragma unroll
        for (int kt = 0; kt < 16; ++kt) { const LAS unsigned char* kp = Ks + (16 * kt + l15) * MA_KS + quad * 16; f32x4 a = (f32x4){0.f, 0.f, 0.f, 0.f};
#pragma unroll
            for (int s4 = 0; s4 < 4; ++s4) a = __builtin_amdgcn_mfma_f32_16x16x32_bf16(*(const LAS bf16x8*)(kp + 64 * s4), bq[s4], a, 0, 0, 0);
            s[kt] = a; if (kt & 1) __builtin_amdgcn_sched_barrier(0); }
        float mx = -1e30f;
#pragma unroll
        for (int kt = 0; kt < 16; ++kt)
#pragma unroll
            for (int v = 0; v < 4; ++v) mx = fmaxf(mx, s[kt][v]);
        mx = fmaxf(mx, shx(mx, 16, lane)); mx = fmaxf(mx, shx(mx, 32, lane));
        float sum = 0.f;
#pragma unroll
        for (int kt = 0; kt < 16; ++kt)
#pragma unroll
            for (int v = 0; v < 4; ++v) { const float e = __builtin_amdgcn_exp2f(s[kt][v] - mx); s[kt][v] = e; sum += e; }
        sum += shx(sum, 16, lane); sum += shx(sum, 32, lane);
        const float inv = 1.0f / sum;
        bf16x8 pb[8];
#pragma unroll
        for (int i = 0; i < 8; ++i) pb[i] = __builtin_bit_cast(bf16x8, pack8(s[2 * i], s[2 * i + 1]));
        unsigned char* op = mix + (size_t)tokq * 2048 + 1536 + head * 128 + 4 * quad;
#pragma unroll 1
        for (int dt = 0; dt < 8; ++dt) { f32x4 o = (f32x4){0.f, 0.f, 0.f, 0.f};
#pragma unroll
            for (int i = 0; i < 8; ++i) { const LAS unsigned char* vp = Vt + (16 * dt + l15) * MA_VS + (32 * i + 4 * quad) * 2;
                const u32x2 x0 = *(const LAS u32x2*)vp, x1 = *(const LAS u32x2*)(vp + 32); const u32x4 av = (u32x4){x0.x, x0.y, x1.x, x1.y};
                o = __builtin_amdgcn_mfma_f32_16x16x32_bf16(__builtin_bit_cast(bf16x8, av), pb[i], o, 0, 0, 0); }
            const float sc8 = inv * FP8_SA; *(unsigned*)(op + 16 * dt) = pk_fp8x4(o[0] * sc8, o[1] * sc8, o[2] * sc8, o[3] * sc8); }
    }
}

__device__ __forceinline__ void ssm_carry(Frame& F, int l, int gb) {
    const int g = gb >> 4, b = gb & 15, p = F.lane; const f32x2 lam = ((const f32x2*)(F.ws + WS_LAM))[(l * 32 + g) * 64 + p];
    const float* S = (const float*)(F.ws + WS_S) + ((size_t)g * 1024 + b * 64) * 128; bf16* U = (bf16*)(F.ws + WS_U) + ((size_t)g * 1024 + b * 64) * UK + 512;
    float xr = 0.f, xi = 0.f; float sr[16], si[16], nsr[16], nsi[16];
#pragma unroll
    for (int j = 0; j < 16; ++j) { sr[j] = S[(size_t)j * 128 + p]; si[j] = S[(size_t)j * 128 + 64 + p]; }
    for (int c0 = 0; c0 < 64; c0 += 16) {
        const int cn = (c0 + 16 < 64) ? c0 + 16 : c0;
#pragma unroll
        for (int j = 0; j < 16; ++j) { nsr[j] = S[(size_t)(cn + j) * 128 + p]; nsi[j] = S[(size_t)(cn + j) * 128 + 64 + p]; }
        asm volatile("" ::: "memory");
#pragma unroll
        for (int j = 0; j < 16; ++j) { U[(size_t)(c0 + j) * UK + p] = (bf16)(pk2(xr, 0.f) & 0xffffu); U[(size_t)(c0 + j) * UK + 64 + p] = (bf16)(pk2(xi, 0.f) & 0xffffu);
            const float nr = lam[0] * xr - lam[1] * xi + sr[j], ni = lam[0] * xi + lam[1] * xr + si[j]; xr = nr; xi = ni; }
#pragma unroll
        for (int j = 0; j < 16; ++j) { sr[j] = nsr[j]; si[j] = nsi[j]; } }
}

__device__ __forceinline__ void ln1_router_phase(Frame& F, const Args& a, int l, int probe) {
    const int lane = F.lane, l15 = lane & 15, quad = lane >> 4, w = F.wave, tid = F.tid;
    LAS f32x2* st = (LAS f32x2*)(F.lds);
    LAS float* lgp = (LAS float*)(F.lds + 1024);
    LAS float* lgall = (LAS float*)(F.lds + 49152);
    LAS int* hist = (LAS int*)(F.lds + 66560); LAS int* ebase = (LAS int*)(F.lds + 66688);
    LAS float* gL = (LAS float*)(F.lds + 32768);
    LAS float* bL = (LAS float*)(F.lds + 32768 + 8192);
    __syncthreads();
    for (int i = tid; i < D; i += NTHR) { gL[i] = a.in[18][l * D + i]; bL[i] = a.in[19][l * D + i]; }
    __syncthreads();
    bf16* hb = (bf16*)(F.ws + WS_HB); bf16* hbo = probe ? (bf16*)(F.ws + WS_ACT) : hb; unsigned char* h8o = probe ? (unsigned char*)(F.ws + WS_OP) : (unsigned char*)(F.ws + WS_H8);
    const bf16* whi = (const bf16*)(F.ws + WS_WRT) + (size_t)(l * 2 + 0) * NE * D + 256 * w + 16 * quad; const bf16* wlo = whi + (size_t)NE * D;
    const int cbase = 256 * w + 16 * quad;
    u32x4 raw[8];
    const float rbias = a.in[21][l * NE + (tid & 31)];
    int tile = F.vcu, step = 0;
    if (tile < T / 16) { const bf16* bp = hb + (size_t)(tile * 16 + l15) * D + cbase;
#pragma unroll
        for (int s = 0; s < 8; ++s) raw[s] = *(const u32x4*)(bp + 64 * (s >> 1) + 8 * (s & 1)); }
    for (; tile < T / 16; tile += F.G) {
        bf16* bp = hb + (size_t)(tile * 16 + l15) * D + cbase;
        f32x4 y[8][2]; float sm = 0.f, sq = 0.f;
#pragma unroll
        for (int s = 0; s < 8; ++s) { y[s][0] = (f32x4){bflo(raw[s].x), bfhi(raw[s].x), bflo(raw[s].y), bfhi(raw[s].y)}; y[s][1] = (f32x4){bflo(raw[s].z), bfhi(raw[s].z), bflo(raw[s].w), bfhi(raw[s].w)};
#pragma unroll
            for (int h2 = 0; h2 < 2; ++h2) { const f32x4 v = y[s][h2]; sm += (v[0] + v[1]) + (v[2] + v[3]); sq += (v[0] * v[0] + v[1] * v[1]) + (v[2] * v[2] + v[3] * v[3]); } }
        bf16x8 rw[2][4];
#define LN1_RW_LOAD(slot, s_) do { const int so_ = 64 * ((s_) >> 1) + 8 * ((s_) & 1); \
            rw[slot][0] = *(const bf16x8*)(whi + (size_t)l15 * D + so_); rw[slot][1] = *(const bf16x8*)(whi + (size_t)(16 + l15) * D + so_); \
            rw[slot][2] = *(const bf16x8*)(wlo + (size_t)l15 * D + so_); rw[slot][3] = *(const bf16x8*)(wlo + (size_t)(16 + l15) * D + so_); } while (0)
        LN1_RW_LOAD(0, 0); LN1_RW_LOAD(1, 1);
        asm volatile("" ::: "memory");
        { const int nt = tile + F.G; if (nt < T / 16) { const bf16* np = hb + (size_t)(nt * 16 + l15) * D + cbase;
#pragma unroll
            for (int s = 0; s < 8; ++s) raw[s] = *(const u32x4*)(np + 64 * (s >> 1) + 8 * (s & 1)); } }
        sm += shx(sm, 16, lane); sm += shx(sm, 32, lane); sq += shx(sq, 16, lane); sq += shx(sq, 32, lane);
        if (quad == 0) st[w * 16 + l15] = (f32x2){sm, sq};
        __syncthreads();
        float ts = 0.f, tq = 0.f;
#pragma unroll
        for (int k = 0; k < 8; ++k) { const f32x2 v = st[k * 16 + l15]; ts += v[0]; tq += v[1]; }
        const float mean = ts * (1.f / D), var = fmaxf(tq * (1.f / D) - mean * mean, 0.f), rstd = 1.f / sqrtf(var + LN_EPS);
        if (w == 0 && quad == 0 && !probe) ((f32x2*)(F.ws + WS_RS))[tile * 16 + l15] = (f32x2){mean, rstd};
        f32x4 acc0 = (f32x4){0.f, 0.f, 0.f, 0.f}, acc1 = acc0; u32x2 q8prev = (u32x2){0u, 0u}; u32x4 h8w[4];
#pragma unroll
        for (int s = 0; s < 8; ++s) { const int so = 64 * (s >> 1) + 8 * (s & 1), c0 = cbase + so;
            const f32x4 g0 = *(const LAS f32x4*)(gL + c0), g1 = *(const LAS f32x4*)(gL + c0 + 4), b0 = *(const LAS f32x4*)(bL + c0), b1 = *(const LAS f32x4*)(bL + c0 + 4);
            const f32x4 y0 = (y[s][0] - mean) * rstd * g0 + b0, y1 = (y[s][1] - mean) * rstd * g1 + b1;
            const u32x4 hi = pack8(y0, y1);
            { u32x2 q8; q8.x = pk_fp8x4(y0[0] * FP8_SA, y0[1] * FP8_SA, y0[2] * FP8_SA, y0[3] * FP8_SA); q8.y = pk_fp8x4(y1[0] * FP8_SA, y1[1] * FP8_SA, y1[2] * FP8_SA, y1[3] * FP8_SA);
              if (s & 1) h8w[s >> 1] = (u32x4){q8prev.x, q8prev.y, q8.x, q8.y}; else q8prev = q8; }
            f32x4 d0, d1;
#pragma unroll
            for (int j = 0; j < 2; ++j) { d0[2 * j] = y0[2 * j] - bflo(hi[j]); d0[2 * j + 1] = y0[2 * j + 1] - bfhi(hi[j]); d1[2 * j] = y1[2 * j] - bflo(hi[2 + j]); d1[2 * j + 1] = y1[2 * j + 1] - bfhi(hi[2 + j]); }
            const bf16x8 ahi = __builtin_bit_cast(bf16x8, hi), alo = __builtin_bit_cast(bf16x8, pack8(d0, d1));
            const bf16x8 bh0 = rw[s & 1][0], bh1 = rw[s & 1][1], bl0 = rw[s & 1][2], bl1 = rw[s & 1][3];
            if (s + 2 < 8) LN1_RW_LOAD(s & 1, s + 2);
            acc0 = __builtin_amdgcn_mfma_f32_16x16x32_bf16(ahi, bh0, acc0, 0, 0, 0); acc0 = __builtin_amdgcn_mfma_f32_16x16x32_bf16(alo, bh0, acc0, 0, 0, 0); acc0 = __builtin_amdgcn_mfma_f32_16x16x32_bf16(ahi, bl0, acc0, 0, 0, 0);
            acc1 = __builtin_amdgcn_mfma_f32_16x16x32_bf16(ahi, bh1, acc1, 0, 0, 0); acc1 = __builtin_amdgcn_mfma_f32_16x16x32_bf16(alo, bh1, acc1, 0, 0, 0); acc1 = __builtin_amdgcn_mfma_f32_16x16x32_bf16(ahi, bl1, acc1, 0, 0, 0); }
#undef LN1_RW_LOAD
#pragma unroll
        for (int k = 0; k < 4; ++k) *(u32x4*)(h8o + (size_t)(tile * 16 + l15) * D + cbase + 64 * k) = h8w[k];
#pragma unroll
        for (int v = 0; v < 4; ++v) { lgp[w * 528 + (4 * quad + v) * 33 + l15] = acc0[v]; lgp[w * 528 + (4 * quad + v) * 33 + 16 + l15] = acc1[v]; }
        __syncthreads();
        { const int r = tid >> 5, e = tid & 31; float t = rbias;
#pragma unroll
          for (int k = 0; k < 8; ++k) t += lgp[k * 528 + r * 33 + e];
          lgall[step * 528 + r * 33 + e] = t; }
        ++step;
    }
    if (probe) { __syncthreads(); return; }
    if (tid < 32) hist[tid] = 0;
    __syncthreads();
    const int nrows = step * 16; int bi[4] = {0, 0, 0, 0}; float gt[4] = {0.f, 0.f, 0.f, 0.f}; int rk[4] = {0, 0, 0, 0}; int row = 0;
    if (tid < nrows) { const int st_ = tid >> 4, r = tid & 15; row = (F.vcu + st_ * F.G) * 16 + r; float bv[4] = {-3e38f, -3e38f, -3e38f, -3e38f};
        for (int e = 0; e < 32; ++e) { float v = lgall[st_ * 528 + r * 33 + e]; int id = e;
#pragma unroll
            for (int k = 0; k < 4; ++k) { if (v > bv[k]) { const float tv = bv[k]; const int ti = bi[k]; bv[k] = v; bi[k] = id; v = tv; id = ti; } } }
        const float e1 = __expf(bv[1] - bv[0]), e2 = __expf(bv[2] - bv[0]), e3 = __expf(bv[3] - bv[0]), inv = 1.0f / (1.0f + e1 + e2 + e3); gt[0] = inv; gt[1] = e1 * inv; gt[2] = e2 * inv; gt[3] = e3 * inv;
#pragma unroll
        for (int k = 0; k < 4; ++k) rk[k] = __hip_atomic_fetch_add(&hist[bi[k]], 1, __ATOMIC_RELAXED, __HIP_MEMORY_SCOPE_WORKGROUP); }
    __syncthreads();
    if (tid < 32) { const int c = hist[tid]; ebase[tid] = c ? (int)__hip_atomic_fetch_add(F.ctl + CW_CNT + (l * 32 + tid) * 64, (unsigned)c, RLX_AGENT) : 0; }
    __syncthreads();
    if (tid < nrows) { int* pe = (int*)(F.ws + WS_PE); int* ps = (int*)(F.ws + WS_PS); float* pg = (float*)(F.ws + WS_PG); int* list = (int*)(F.ws + WS_LIST);
#pragma unroll
        for (int k = 0; k < 4; ++k) { const int e = bi[k], slot = ebase[e] + rk[k]; pe[row * 4 + k] = e; ps[row * 4 + k] = slot; pg[row * 4 + k] = gt[k]; list[e * 32768 + slot] = row; } }
    __syncthreads();
}

__device__ __forceinline__ void combine_ln2_phase(Frame& F, const Args& a, int l, int gw, int NGW, int probe) {
    const int lane = F.lane; const int* pe = (const int*)(F.ws + WS_PE); const int* ps = (const int*)(F.ws + WS_PS); const float* pg = (const float*)(F.ws + WS_PG);
    volatile LAS int* tst = (volatile LAS int*)(F.lds + MISC_OFF + MO_TST); const unsigned char* op = (const unsigned char*)(F.ws + WS_OP); bf16* hb = (bf16*)(F.ws + WS_HB);
    const float* g = a.in[26] + l * D; const float* b = a.in[27] + l * D;
    f32x4 g1v[8], b1v[8];
#pragma unroll
    for (int j = 0; j < 4; ++j) { const int c = 8 * lane + 512 * j; g1v[2 * j] = *(const f32x4*)(a.in[18] + l * D + c); g1v[2 * j + 1] = *(const f32x4*)(a.in[18] + l * D + c + 4);
        b1v[2 * j] = *(const f32x4*)(a.in[19] + l * D + c); b1v[2 * j + 1] = *(const f32x4*)(a.in[19] + l * D + c + 4); }
    const f32x2* rs = (const f32x2*)(F.ws + WS_RS);
    int row = gw; if (row >= T) return;
    typedef int i32x4 __attribute__((ext_vector_type(4)));
    i32x4 e4 = *(const i32x4*)(pe + row * 4), s4 = *(const i32x4*)(ps + row * 4); f32x4 g4 = *(const f32x4*)(pg + row * 4);
    for (; row < T; row += NGW) {
        const int nrow = row + NGW; i32x4 ne4 = e4, ns4 = s4; f32x4 ng4 = g4;
        if (nrow < T) { ne4 = *(const i32x4*)(pe + nrow * 4); ns4 = *(const i32x4*)(ps + nrow * 4); ng4 = *(const f32x4*)(pg + nrow * 4); }
        u32x4 hw[4]; u32x2 ow[4][4]; const f32x2 st = rs[row];
#pragma unroll
        for (int j = 0; j < 4; ++j) hw[j] = *(const u32x4*)(hb + (size_t)row * D + 8 * lane + 512 * j);
#pragma unroll
        for (int k = 0; k < 4; ++k) { const unsigned char* r = op + ((size_t)tst[e4[k]] * 256 + s4[k]) * 2048 + 8 * lane;
#pragma unroll
            for (int j = 0; j < 4; ++j) ow[k][j] = *(const u32x2*)(r + 512 * j); }
        f32x4 v[8]; float s = 0.f;
#pragma unroll
        for (int j = 0; j < 4; ++j) { const float ms = st[0], rr = st[1] * DN_ALPHA;
            v[2 * j] = ((f32x4){bflo(hw[j].x), bfhi(hw[j].x), bflo(hw[j].y), bfhi(hw[j].y)} - ms) * rr * g1v[2 * j] + b1v[2 * j] * DN_ALPHA;
            v[2 * j + 1] = ((f32x4){bflo(hw[j].z), bfhi(hw[j].z), bflo(hw[j].w), bfhi(hw[j].w)} - ms) * rr * g1v[2 * j + 1] + b1v[2 * j + 1] * DN_ALPHA;
#pragma unroll
            for (int k = 0; k < 4; ++k) { const u32x2 w = ow[k][j]; const float gk = g4[k] * (1.0f / FP8_SO);
                const f32x2 a0 = __builtin_amdgcn_cvt_pk_f32_fp8(w.x, false), a1 = __builtin_amdgcn_cvt_pk_f32_fp8(w.x, true), a2 = __builtin_amdgcn_cvt_pk_f32_fp8(w.y, false), a3 = __builtin_amdgcn_cvt_pk_f32_fp8(w.y, true);
                v[2 * j] += (f32x4){a0[0], a0[1], a1[0], a1[1]} * gk; v[2 * j + 1] += (f32x4){a2[0], a2[1], a3[0], a3[1]} * gk; } }
#pragma unroll
        for (int j = 0; j < 8; ++j) s += (v[j][0] + v[j][1]) + (v[j][2] + v[j][3]);
        const float mean = wave_sum(s, lane) * (1.f / D); float s2 = 0.f;
#pragma unroll
        for (int j = 0; j < 8; ++j) { v[j] = v[j] - mean; s2 += (v[j][0] * v[j][0] + v[j][1] * v[j][1]) + (v[j][2] * v[j][2] + v[j][3] * v[j][3]); }
        const float rstd = 1.f / sqrtf(wave_sum(s2, lane) * (1.f / D) + LN_EPS);
#pragma unroll
        for (int j = 0; j < 4; ++j) { const int c = 8 * lane + 512 * j; const f32x4 g0 = *(const f32x4*)(g + c), g1 = *(const f32x4*)(g + c + 4), b0 = *(const f32x4*)(b + c), b1 = *(const f32x4*)(b + c + 4);
            const f32x4 y0 = v[2 * j] * rstd * g0 + b0, y1 = v[2 * j + 1] * rstd * g1 + b1;
            if (probe) { *(u32x4*)((bf16*)(F.ws + WS_ACT) + (size_t)row * D + c) = pack8(y0, y1); if (l == NL - 1) *(u32x4*)((bf16*)(F.ws + WS_MRG) + (size_t)row * D / 2 + c / 2) = pack8(y0, y1); }
            else if (l == NL - 1) { float* o = a.out + (size_t)row * D + c; *(f32x4*)o = y0; *(f32x4*)(o + 4) = y1; }
            else { *(u32x4*)(hb + (size_t)row * D + c) = pack8(y0, y1);
                u32x2 q8; q8.x = pk_fp8x4(y0[0] * FP8_SA, y0[1] * FP8_SA, y0[2] * FP8_SA, y0[3] * FP8_SA); q8.y = pk_fp8x4(y1[0] * FP8_SA, y1[1] * FP8_SA, y1[2] * FP8_SA, y1[3] * FP8_SA);
                *(u32x2*)((unsigned char*)(F.ws + WS_H8) + (size_t)row * D + c) = q8;
                *(unsigned*)((unsigned char*)(F.ws + WS_H4) + (size_t)row * (D / 2) + (c >> 1)) = pk_fp4x8(y0, y1, FP4_SA); } }
        e4 = ne4; s4 = ns4; g4 = ng4;
    }
}

constexpr int PH_PER_LAYER = 11, N_PHASES = 1 + NL * PH_PER_LAYER;
__global__ void __launch_bounds__(NTHR, 2) mk_fwd(Args args) {
    extern __shared__ __attribute__((aligned(16))) unsigned char lds_raw[];
    Frame F;
    F.lds = (LAS unsigned char*)lds_raw; F.MISC = (volatile LAS unsigned*)(F.lds + MISC_OFF);
    F.tid = threadIdx.x; F.lane = F.tid & 63; F.wave = __builtin_amdgcn_readfirstlane(F.tid >> 6);
    F.G = gridDim.x; { const int bx = blockIdx.x; F.vcu = (bx & 7) * (F.G >> 3) + (bx >> 3); }
    F.ws = args.ws; F.ctl = (unsigned*)(args.ws + WS_CTL);
    for (int u = F.tid; u < (LDS_BYTES - MISC_OFF) / 4; u += NTHR) ((LAS unsigned*)(F.lds + MISC_OFF))[u] = 0u;
    __syncthreads();
#if !MK_PER_PHASE
    XcdBarrier bar = xcd_barrier_post(F.ctl + CW_BAR, F.MISC + MO_BAR / 4);
#define GRID_BAR() xcd_barrier(bar)
#else
#define GRID_BAR() do { } while (0)
#endif
    const int lo = args.ph_lo, hi = args.ph_hi;
#ifndef ONLY_PH
#define ONLY_PH -1
#endif
#define EN(o) (ONLY_PH < 0 || ONLY_PH == (o))
#ifndef DBL_MASK
#define DBL_MASK 0
#endif

#define REPS(o) (((DBL_MASK >> (o)) & 1) ? 2 : 1)
#define IN(k) (lo <= (k) && (k) < hi)
#define SEAM(k) do { if (IN(k) && IN((k) + 1)) GRID_BAR(); } while (0)
    const int cidx = (int)blockIdx.x;
#define WS_FRESH2() size_t z2_ = 0; asm volatile("" : "+s"(z2_)); unsigned char* ws2 = args.ws + z2_
#define WS_FRESH() size_t z_ = 0; asm volatile("" : "+s"(z_)); unsigned char* ws = args.ws + z_; F.ws = ws; F.ctl = (unsigned*)(ws + WS_CTL); \
    { int t_ = threadIdx.x; asm volatile("" : "+v"(t_)); F.tid = t_; F.lane = t_ & 63; F.wave = __builtin_amdgcn_readfirstlane(t_ >> 6); \
      int bx_ = blockIdx.x; asm volatile("" : "+s"(bx_)); F.vcu = (bx_ & 7) * (F.G >> 3) + (bx_ >> 3); } \
    const int gw = F.vcu * NWAVES + F.wave, NGW = F.G * NWAVES; (void)gw; (void)NGW

    if (EN(100) && IN(0)) for (int rep_ = 0; rep_ < REPS(11); ++rep_) { WS_FRESH(); p0_prologue(F, args); }
    SEAM(0);
    for (int l = 0; l < NL; ++l) {
        const int pb = 1 + l * PH_PER_LAYER;
        if (EN(0) && IN(pb + 0)) for (int rep_ = 0; rep_ < REPS(0); ++rep_) { WS_FRESH(); asm volatile("; MARK_PHASE_0" ::: "memory");
            PInproj P; P.lda = 2048; P.ldb = 2048; P.hb = (const char*)(ws + WS_H8); P.win = (const char*)(ws + WS_WIN) + (size_t)l * INW * D; P.memb = (const char*)(ws + WS_MEMB); P.wmkv = (const char*)(ws + WS_WMKV);
            P.G = F.G; P.c = cidx; P.nextra = (l == 0) ? 128 : 0; P.mode = 0; P.i0 = 0; P.i1 = 1 << 20;
            P.q = (bf16*)(ws + WS_Q); P.kv = (bf16*)(ws + WS_KV); P.U = (bf16*)(ws + WS_U); P.qm = (bf16*)(ws + WS_QM); P.mkv = (bf16*)(ws + WS_MKV); P.gates = (unsigned char*)(ws + WS_G);
            P.probe_ = (PROBE_VARIANT != 0) ? rep_ : 0;
            pg8::gemm_phase(F.lds, P);
        }
        SEAM(pb + 0);
        if (EN(1) && IN(pb + 1)) for (int rep_ = 0; rep_ < REPS(1); ++rep_) { WS_FRESH(); asm volatile("; MARK_PHASE_1" ::: "memory");
            { PSsmState P; P.lda = UK * 2; P.ldb = 1024; P.U = (const char*)(ws + WS_U); P.Wst = (const char*)(ws + WS_WST) + (size_t)l * 32 * 256 * 1024; P.G = F.G; P.c = cidx; P.S = (float*)(ws + WS_S);
              pg8::gemm_phase(F.lds, P); }
            if (cidx < 128) { if (F.wave < 4) ssm_carry(F, l, (cidx >> 2) * 16 + (cidx & 3) * 4 + F.wave); VM_WAIT(); }
            __syncthreads();
            { PSsmOut P; P.lda = UK * 2; P.ldb = UK * 2; P.U = (const char*)(ws + WS_U); P.W1 = (const char*)(ws + WS_W1S) + (size_t)l * 32 * 512 * UK * 2; P.G = F.G; P.c = cidx; P.z = (bf16*)(ws + WS_Z);
              pg8::gemm_phase(F.lds, P); }
            if (F.G == 256) {
                const int nu = (cidx < 128) ? 1 : 3, u0 = (cidx < 128) ? cidx : 128 + (cidx - 128) * 3;
                for (int j = 0; j < nu; ++j) swa_unit(F, u0 + j, (const bf16*)(ws + WS_Q), (const bf16*)(ws + WS_KV), args.in[5] + l * 16, (unsigned char*)(ws + WS_MIX));
                for (int j = 0; j < nu; ++j) memattn_unit(F, u0 + j, l, (const bf16*)(ws + WS_QM), (const bf16*)(ws + WS_MKV), (unsigned char*)(ws + WS_MIX));
            } else {
                for (int u = F.vcu; u < 512; u += F.G) swa_unit(F, u, (const bf16*)(ws + WS_Q), (const bf16*)(ws + WS_KV), args.in[5] + l * 16, (unsigned char*)(ws + WS_MIX));
                for (int u = F.vcu; u < 512; u += F.G) memattn_unit(F, u, l, (const bf16*)(ws + WS_QM), (const bf16*)(ws + WS_MKV), (unsigned char*)(ws + WS_MIX));
            }
        }
        SEAM(pb + 1);
        if (EN(4) && IN(pb + 4)) for (int rep_ = 0; rep_ < REPS(4); ++rep_) { WS_FRESH(); asm volatile("; MARK_PHASE_4" ::: "memory");
            { PGlu P; P.lda = 1024; P.ldb = 1024; P.z = (const char*)(ws + WS_Z); P.wg = (const char*)(ws + WS_WGLU) + (size_t)l * 1024 * 512 * 2; P.G = F.G; P.c = cidx; P.mix = (unsigned char*)(ws + WS_MIX);
              pg8::gemm_phase(F.lds, P); }
            { PInGate4 P; P.lda = 1024; P.ldb = 1024; P.h4 = (const char*)(ws + WS_H4); P.win4 = (const char*)(ws + WS_WIN4) + (size_t)l * 6144 * (D / 2); P.G = F.G; P.c = cidx; P.gates = (unsigned char*)(ws + WS_G);
              pg8::gemm_phase(F.lds, P); }
        }
        SEAM(pb + 4);
        if (EN(5) && IN(pb + 5)) for (int rep_ = 0; rep_ < REPS(5); ++rep_) { WS_FRESH(); asm volatile("; MARK_PHASE_5" ::: "memory");
            PBranch P; P.lda = 2048; P.ldb = 2048; P.mix = (const char*)(ws + WS_MIX); P.wb = (const char*)(ws + WS_WBR) + (size_t)l * D * D; P.G = F.G; P.c = cidx; P.gates = (const unsigned char*)(ws + WS_G); P.mrg = (unsigned char*)(ws + WS_MRG);
            pg8::gemm_phase(F.lds, P);
        }
        SEAM(pb + 5);
        if (EN(6) && IN(pb + 6)) { WS_FRESH(); asm volatile("; MARK_PHASE_6" ::: "memory");
            PWout P; P.lda = 2048; P.ldb = 2048; P.mrg = (const char*)(ws + WS_MRG); P.wo = (const char*)(ws + WS_WOUT) + (size_t)l * D * D; P.G = F.G; P.c = cidx; P.h = (bf16*)(ws + WS_HB);
            pg8::gemm_phase(F.lds, P);
        }
        SEAM(pb + 6);
        if (EN(7) && IN(pb + 7)) for (int rep_ = 0; rep_ < REPS(7); ++rep_) { WS_FRESH(); asm volatile("; MARK_PHASE_7" ::: "memory"); ln1_router_phase(F, args, l, rep_); }
        SEAM(pb + 7);
        if (EN(8) && IN(pb + 8)) for (int rep_ = 0; rep_ < REPS(8); ++rep_) { WS_FRESH(); asm volatile("; MARK_PHASE_8" ::: "memory");
            moe_tables(F, l);
            const int rc = (l == 0) ? (cidx * 16) / F.G : 0;
            for (int part = 0; part < 2; ++part) {
                { WS_FRESH2();
                  PMoeUp P; P.lda = 2048; P.ldb = 2048; P.hb = (const char*)(ws2 + WS_H8); P.wup = (const char*)(ws2 + WS_WUP) + (size_t)l * NE * D * D; P.G = F.G; P.c = cidx;
                  P.list = (const int*)(ws2 + WS_LIST); P.bup = args.in[23] + (size_t)l * NE * 2048; P.act = (unsigned char*)(ws2 + WS_ACT); P.misc = F.lds + MISC_OFF;
                  P.i0 = part ? rc : 0; P.i1 = part ? (1 << 20) : rc;
                  pg8::gemm_phase(F.lds, P); }
                if (part == 0 && l == 0) { __syncthreads(); t_run<true>(F, args, 2, gw, NGW); __syncthreads(); } }
        }
        SEAM(pb + 8);
        if (EN(9) && IN(pb + 9)) for (int rep_ = 0; rep_ < REPS(9); ++rep_) { WS_FRESH(); asm volatile("; MARK_PHASE_9" ::: "memory");
            moe_tables(F, l);
            PMoeDown P; P.lda = 1024; P.ldb = 1024; P.act = (const char*)(ws + WS_ACT); P.wdn = (const char*)(ws + WS_WDN) + (size_t)l * NE * D * DFF; P.G = F.G; P.c = cidx;
            P.bdn = args.in[25] + (size_t)l * NE * 2048; P.op = (unsigned char*)(ws + WS_OP); P.misc = F.lds + MISC_OFF;
            pg8::gemm_phase(F.lds, P);
        }
        SEAM(pb + 9);
        if (EN(10) && IN(pb + 10)) { WS_FRESH(); asm volatile("; MARK_PHASE_10" ::: "memory"); moe_tables(F, l); for (int rep_ = REPS(10) - 1; rep_ >= 0; --rep_) combine_ln2_phase(F, args, l, gw, NGW, rep_); }
        SEAM(pb + 10); asm volatile("; MARK_PHASE_END" ::: "memory");
    }
#undef IN
#undef SEAM
}

extern "C" void kernel_launch(void* const* d_in, const int* in_sizes, int n_in, void* d_out, int out_size, void* d_ws, size_t ws_size, hipStream_t stream) {
    static int grid = 0;
    if (grid == 0) {
        if (n_in != 28 || out_size != T * D || ws_size < WS_END) { fprintf(stderr, "kernel_launch: unexpected shapes (n_in %d out %d ws %zu need %zu)\n", n_in, out_size, ws_size, (size_t)WS_END); grid = -1; return; }
        int dev = 0, cus = 0, per_cu = 0;
        if (hipGetDevice(&dev) != hipSuccess || hipDeviceGetAttribute(&cus, hipDeviceAttributeMultiprocessorCount, dev) != hipSuccess) { grid = -1; return; }
        if (hipFuncSetAttribute((const void*)mk_fwd, hipFuncAttributeMaxDynamicSharedMemorySize, LDS_BYTES) != hipSuccess) { fprintf(stderr, "kernel_launch: hipFuncSetAttribute failed\n"); grid = -1; return; }
        if (hipOccupancyMaxActiveBlocksPerMultiprocessor(&per_cu, (const void*)mk_fwd, NTHR, LDS_BYTES) != hipSuccess || per_cu < 1) fprintf(stderr, "kernel_launch: occupancy query reports %d\n", per_cu);
        (void)hipGetLastError();
        grid = cus;
        if (cus != 256) { fprintf(stderr, "kernel_launch: built for a 256-CU MI355X (found %d CUs); nothing launched\n", cus); grid = -1; return; }
    }
    if (grid < 0) return;
    if (hipMemsetAsync((char*)d_ws + WS_CTL, 0, CTL_ZERO_BYTES, stream) != hipSuccess) return;
    Args a{};
    for (int i = 0; i < 28; ++i) a.in[i] = (const float*)d_in[i];
    a.out = (float*)d_out; a.ws = (unsigned char*)d_ws;
#if MK_PER_PHASE
    for (int p = 0; p < N_PHASES; ++p) { a.ph_lo = p; a.ph_hi = p + 1; hipLaunchKernelGGL(mk_fwd, dim3(grid), dim3(NTHR), LDS_BYTES, stream, a); }
#else
    a.ph_lo = 0; a.ph_hi = N_PHASES; hipLaunchKernelGGL(mk_fwd, dim3(grid), dim3(NTHR), LDS_BYTES, stream, a);
#endif
}
```

```cpp
#include <hip/hip_runtime.h>
#include <cstdio>
#include <cstdint>

#ifndef PROBE_VARIANT
#define PROBE_VARIANT 0
#endif
#ifndef MK_PER_PHASE
#define MK_PER_PHASE 0
#endif

#define GAS __attribute__((address_space(1)))
#define LAS __attribute__((address_space(3)))
typedef unsigned short bf16;
typedef short bf16x8 __attribute__((ext_vector_type(8)));
typedef short bf16x16 __attribute__((ext_vector_type(16)));
typedef float f32x4 __attribute__((ext_vector_type(4)));
typedef float f32x2 __attribute__((ext_vector_type(2)));
typedef unsigned u32x4 __attribute__((ext_vector_type(4)));
typedef unsigned u32x2 __attribute__((ext_vector_type(2)));
typedef __bf16 bf16x2_t __attribute__((ext_vector_type(2)));
typedef int i32x8 __attribute__((ext_vector_type(8)));

constexpr int T = 32768, D = 2048, NL = 2, SEQ = 2048, NBATCH = 16;
constexpr int INW = 8448, NE = 32, DFF = 1024, NMEM = 256;
constexpr int NWAVES = 8, NTHR = 512;
constexpr float LN_EPS = 1e-5f;
constexpr float DN_ALPHA = 1.4142135623730951f;
constexpr int PADROWS = 139264;
constexpr int LCH = 32, NCH = SEQ / LCH;
constexpr int UK = 640;

constexpr size_t WS_CTL  = 0, CTL_ZERO_BYTES = 1u << 20;
constexpr size_t WS_WIN  = 1u << 20;
constexpr size_t WS_WIN8 = WS_WIN + (size_t)2 * 2304 * D * 2;
constexpr size_t WS_WGLU = WS_WIN  + (size_t)2 * INW * D * 2;
constexpr size_t WS_WMKV = WS_WGLU + (size_t)2 * 1024 * 512 * 2;
constexpr size_t WS_WBR  = WS_WMKV + (size_t)2 * 1024 * D * 2;
constexpr size_t WS_WOUT = WS_WBR  + (size_t)2 * D * D * 2;
constexpr size_t WS_WUP  = WS_WOUT + (size_t)2 * D * D * 2;
constexpr size_t WS_WDN  = WS_WUP  + (size_t)2 * NE * D * D * 2;
constexpr size_t WS_WRT  = WS_WDN  + (size_t)2 * NE * D * DFF * 2;
constexpr size_t WS_W1S  = WS_WRT  + (size_t)2 * 2 * NE * D * 2;
constexpr size_t WS_WST  = WS_W1S  + (size_t)2 * 32 * 512 * UK * 2;
constexpr size_t WS_LAM  = WS_WST  + (size_t)2 * 32 * 256 * 512 * 2;
constexpr size_t WS_H32  = WS_LAM  + (size_t)2 * 32 * 64 * 8;
constexpr size_t WS_H8   = WS_H32;
constexpr size_t WS_H4   = WS_H32 + (size_t)T * D;
constexpr size_t WS_WIN4 = WS_WIN + (size_t)2 * INW * D;
constexpr size_t WS_HB   = WS_H32  + (size_t)T * D * 4;
constexpr size_t WS_MEMB = WS_HB   + (size_t)T * D * 2;
constexpr size_t WS_Q    = WS_MEMB + (size_t)4096 * D * 2;
constexpr size_t WS_KV   = WS_Q    + (size_t)T * 1024 * 2;
constexpr size_t WS_U    = WS_KV   + (size_t)T * 256 * 2;
constexpr size_t WS_QM   = WS_U    + (size_t)32 * 1024 * UK * 2;
constexpr size_t WS_G    = WS_QM   + (size_t)T * 512 * 2;
constexpr size_t WS_MKV  = WS_G    + (size_t)T * 6144 * 2;
constexpr size_t WS_MIX  = WS_MKV  + (size_t)4096 * 2048 * 2;
constexpr size_t WS_Z    = WS_MIX  + (size_t)T * 2048 * 2;
constexpr size_t WS_S    = WS_Z    + (size_t)T * 512 * 2;
constexpr size_t WS_MRG  = WS_S    + (size_t)32 * 1024 * 128 * 4;
constexpr size_t WS_ACT  = WS_MRG  + (size_t)T * 2048 * 2;
constexpr size_t WS_OP   = WS_ACT  + (size_t)PADROWS * 1024 * 2;
constexpr size_t WS_PE   = WS_OP   + (size_t)PADROWS * 2048 * 2;
constexpr size_t WS_PS   = WS_PE   + (size_t)T * 4 * 4;
constexpr size_t WS_PG   = WS_PS   + (size_t)T * 4 * 4;
constexpr size_t WS_LIST = WS_PG   + (size_t)T * 4 * 4;
constexpr size_t WS_RS   = WS_LIST + (size_t)32 * 32768 * 4;
constexpr size_t WS_END  = WS_RS + (size_t)T * 8;

constexpr int CW_TMO = 0, CW_CODE = 1;
constexpr int CW_BAR = 4096;
constexpr int CW_CNT = 16384;
constexpr int CW_TQ = 24576;

constexpr int RING_BYTES = 139264;
constexpr int MISC_OFF = RING_BYTES;
constexpr int LDS_BYTES = 147456;
constexpr int MO_BAR = 0, MO_CNT = 64, MO_TST = 192, MO_NT = 352, MO_TE = 512;

#define LDS_WAIT() asm volatile("s_waitcnt lgkmcnt(0)" ::: "memory")
#define VM_WAIT() asm volatile("s_waitcnt vmcnt(0)" ::: "memory")
#define RLX_AGENT __ATOMIC_RELAXED, __HIP_MEMORY_SCOPE_AGENT
__device__ __forceinline__ unsigned pk2(float a, float b) { f32x2 v = {a, b}; bf16x2_t r = __builtin_convertvector(v, bf16x2_t); return __builtin_bit_cast(unsigned, r); }
__device__ __forceinline__ u32x4 pack8(const f32x4 a, const f32x4 b) { u32x4 w; w.x = pk2(a[0], a[1]); w.y = pk2(a[2], a[3]); w.z = pk2(b[0], b[1]); w.w = pk2(b[2], b[3]); return w; }
__device__ __forceinline__ unsigned pk_fp8x4(float a, float b, float c, float d) {
    a = fminf(fmaxf(a, -448.f), 448.f); b = fminf(fmaxf(b, -448.f), 448.f); c = fminf(fmaxf(c, -448.f), 448.f); d = fminf(fmaxf(d, -448.f), 448.f);
    unsigned w = 0u; w = __builtin_amdgcn_cvt_pk_fp8_f32(a, b, w, false); w = __builtin_amdgcn_cvt_pk_fp8_f32(c, d, w, true); return w; }
constexpr float FP4_SA = 2.0f, FP4_SW = 2.0f * 45.254833995939045f, FP4_DESCALE = 1.0f / (FP4_SA * FP4_SW);
__device__ __forceinline__ unsigned pk_fp4x8(const f32x4 a, const f32x4 b, float sc) { unsigned w = 0u;
    w = __builtin_amdgcn_cvt_scalef32_pk_fp4_f32(w, a[0] * sc, a[1] * sc, 1.0f, 0); w = __builtin_amdgcn_cvt_scalef32_pk_fp4_f32(w, a[2] * sc, a[3] * sc, 1.0f, 1);
    w = __builtin_amdgcn_cvt_scalef32_pk_fp4_f32(w, b[0] * sc, b[1] * sc, 1.0f, 2); w = __builtin_amdgcn_cvt_scalef32_pk_fp4_f32(w, b[2] * sc, b[3] * sc, 1.0f, 3); return w; }
constexpr float FP8_SO = 64.0f;
constexpr float FP8_SA = 8.0f, FP8_SW = 512.0f, FP8_DESCALE = 1.0f / (8.0f * 512.0f);
__device__ __forceinline__ float bf2f(unsigned short h) { return __builtin_bit_cast(float, (unsigned)h << 16); }
__device__ __forceinline__ float bflo(unsigned w) { return __builtin_bit_cast(float, w << 16); }
__device__ __forceinline__ float bfhi(unsigned w) { return __builtin_bit_cast(float, w & 0xffff0000u); }
__device__ __forceinline__ float fsigmoid(float x) { return __builtin_amdgcn_rcpf(1.0f + __expf(-x)); }
__device__ __forceinline__ float shx(float v, int m, int lane) { return __builtin_bit_cast(float, __builtin_amdgcn_ds_bpermute((lane ^ m) << 2, __builtin_bit_cast(int, v))); }
__device__ __forceinline__ float wave_sum(float v, int lane) {
#pragma unroll
    for (int o = 1; o < 64; o <<= 1) v += shx(v, o, lane);
    return v;
}

#define XB_TMO      128
#define XB_XCNT(j)  (256  + 64 * (j))
#define XB_XSUB(j)  (1280 + 64 * (j))
#define XB_XGEN(j)  (2304 + 64 * (j))
#define XB_TOP      3328
#define XB_TOPGEN   3392
#define XCD_BAR_WORDS 3456
#define XB_SPIN_CAP (1u << 18)

__device__ __forceinline__ unsigned xb_ld(unsigned* p)              { return __hip_atomic_load(p, __ATOMIC_RELAXED, __HIP_MEMORY_SCOPE_AGENT); }
__device__ __forceinline__ unsigned xb_add(unsigned* p, unsigned v) { return __hip_atomic_fetch_add(p, v, __ATOMIC_RELAXED, __HIP_MEMORY_SCOPE_AGENT); }
__device__ __forceinline__ unsigned xb_xcc_id() { return (unsigned)__builtin_amdgcn_s_getreg((3 << 11) | 20) & 0xFu; }
#define XB_SPIN(cond, bar) do { unsigned _sp = 0; while (cond) { __builtin_amdgcn_s_sleep(1); \
    if ((++_sp & 255u) == 0u) { if (xb_ld(&(bar)[XB_TMO])) break; if (_sp > XB_SPIN_CAP) { atomicAdd(&(bar)[XB_TMO], 1u); break; } } } } while (0)

struct XcdBarrier { unsigned* bar; unsigned x; volatile LAS unsigned* st; };

__device__ __forceinline__ XcdBarrier xcd_barrier_post(unsigned* bar, volatile LAS unsigned* st) {
    XcdBarrier b; b.bar = bar; b.x = xb_xcc_id(); b.st = st;
    if (threadIdx.x == 0) (void)xb_add(&bar[XB_XCNT(b.x)], 1u);
    return b;
}
__device__ __forceinline__ void xcd_barrier_complete(unsigned* bar, unsigned x, unsigned& nloc, unsigned& nx) {
    const unsigned G = gridDim.x * gridDim.y * gridDim.z;
    unsigned sum, cnt, mine, sp = 0u;
    for (;;) {
        sum = 0u; cnt = 0u; mine = 0u;
#pragma unroll
        for (unsigned j = 0; j < 16; ++j) { const unsigned c = xb_ld(&bar[XB_XCNT(j)]); sum += c; cnt += (c > 0u) ? 1u : 0u; mine = (j == x) ? c : mine; }
        if (sum == G) break;
        __builtin_amdgcn_s_sleep(1);
        if ((++sp & 255u) == 0u) { if (xb_ld(&bar[XB_TMO])) break; if (sp > XB_SPIN_CAP) { atomicAdd(&bar[XB_TMO], 1u); break; } }
    }
    nloc = mine > 0u ? mine : 1u; nx = cnt > 0u ? cnt : 1u;
}
__device__ __forceinline__ void xcd_barrier(const XcdBarrier& b) {
    asm volatile("s_waitcnt vmcnt(0)" ::: "memory");
    __syncthreads();
    if (threadIdx.x == 0) {
        unsigned* bar = b.bar;
        __builtin_amdgcn_s_waitcnt(0);
        unsigned nloc = b.st[0], nx = b.st[1];
        if (nloc == 0u) { xcd_barrier_complete(bar, b.x, nloc, nx); b.st[0] = nloc; b.st[1] = nx; }
        const unsigned old = xb_add(&bar[XB_XSUB(b.x)], 1u);
        const unsigned gen = old / nloc;
        if (old + 1u == (gen + 1u) * nloc) {
            __builtin_amdgcn_fence(__ATOMIC_RELEASE, "agent");
            asm volatile("s_waitcnt vmcnt(0)" ::: "memory");
            const unsigned og = xb_add(&bar[XB_TOP], 1u);
            const unsigned tg = og / nx;
            if (og + 1u == (tg + 1u) * nx) xb_add(&bar[XB_TOPGEN], 1u);
            else XB_SPIN(xb_ld(&bar[XB_TOPGEN]) == tg, bar);
            __builtin_amdgcn_fence(__ATOMIC_ACQUIRE, "agent");
            xb_add(&bar[XB_XGEN(b.x)], 1u);
            asm volatile("s_waitcnt vmcnt(0)" ::: "memory");
        } else {
            XB_SPIN(xb_ld(&bar[XB_XGEN(b.x)]) == gen, bar);
            __builtin_amdgcn_fence(__ATOMIC_ACQUIRE, "agent");
            asm volatile("s_waitcnt vmcnt(0)" ::: "memory");
        }
    }
    __syncthreads();
}

namespace pg8 {
constexpr int BM = 256, BK = 64, HALF = 128, HTB = HALF * BK * 2, STAGE_BYTES = 8 * HTB, NXCD = 8, WGM = 8;
__host__ __device__ __forceinline__ int lds_byte(int r, int c) { const int st = (r >> 4) * 2 + (c >> 5), rr = r & 15, cc = c & 31, ob = rr * 64 + cc * 2; return st * 1024 + (ob ^ (((ob >> 9) & 1) << 5)); }
__host__ __device__ __forceinline__ void stage_rc(int b, int& R, int& C) { const int st = b / 1024, sb = b % 1024, swz = sb ^ (((sb >> 9) & 1) << 5); R = (st >> 1) * 16 + swz / 64; C = (st & 1) * 32 + (swz % 64) / 2; }
__host__ __device__ __forceinline__ int perm32(int rho) { const int n = rho >> 4, i = rho & 15; return 8 * (i >> 2) + 4 * n + (i & 3); }

struct GUnit { const char* A; const char* B; int nt, keep, pm, pn, aux, slot; };

__device__ __forceinline__ void tile_map(int L, int nM, int nN, int& pm, int& pn) {
    const int nwg = nM * nN; int wgid = L;
    { const int q = nwg / NXCD, r = nwg % NXCD, xcd = wgid % NXCD, off = wgid / NXCD; wgid = (xcd < r ? xcd * (q + 1) : r * (q + 1) + (xcd - r) * q) + off; }
    const int nig = WGM * nN, gid = wgid / nig, fm = gid * WGM, gsz = (nM - fm) < WGM ? (nM - fm) : WGM;
    pm = fm + ((wgid % nig) % gsz); pn = (wgid % nig) / gsz;
}

template <class P>
__device__ __forceinline__ void gemm_phase(LAS unsigned char* lds, const P& Pb) {
    int tid = threadIdx.x; asm volatile("" : "+v"(tid));
    const int wid = __builtin_amdgcn_readfirstlane(tid >> 6), lane = tid & 63, wr = wid >> 2, wc = wid & 3, fr = lane & 15, fq = lane >> 4;
    const unsigned lda = Pb.lda, ldb = Pb.ldb;
    unsigned voffA[2], voffB[2]; int RA[2], CA[2];
#pragma unroll
    for (int i = 0; i < 2; ++i) { int R, C; stage_rc(tid * 16 + i * 8192, R, C); const int p32 = perm32(R & 31), Rb = (R >> 5) * 64 + (p32 >> 3) * 16 + (p32 & 7);
        RA[i] = R; CA[i] = C; voffA[i] = (unsigned)R * lda + (unsigned)C * 2u; voffB[i] = (unsigned)Rb * ldb + (unsigned)C * 2u; }
    const size_t kstep = (size_t)(BK * 2);
    const size_t hstepA = P::GATHER ? (size_t)0 : (size_t)HALF * lda;
    const size_t hstepB = (size_t)8 * ldb;
    const unsigned ldsw = (unsigned)wid * 1024u;
    const int aoff = lds_byte(wr * 64 + fr, fq * 8), boff = lds_byte(wc * 32 + fr, fq * 8);
#define PG8_SA(b, h) (((b) * 2 + (h)) * HTB)
#define PG8_SB(b, h) ((4 + (b) * 2 + (h)) * HTB)
#define PG8_STAGE(bufoff, gbase, voff) do { if (PROBE_VARIANT == 5 && Pb.probe_) break; _Pragma("unroll") for (int _i = 0; _i < 2; ++_i) \
        __builtin_amdgcn_global_load_lds((const unsigned*)((const char*)(gbase) + (voff)[_i]), (LAS unsigned*)(lds + (bufoff) + ldsw + _i * 8192), 16, 0, 0); } while (0)
#define PG8_LDA(dst, b, h) do { _Pragma("unroll") for (int m = 0; m < 4; ++m) _Pragma("unroll") for (int k = 0; k < 2; ++k) dst[m][k] = *(const LAS bf16x8*)(lds + PG8_SA(b, h) + aoff + m * 2048 + k * 1024); } while (0)
#define PG8_LDB(dst, b, h) do { _Pragma("unroll") for (int n = 0; n < 2; ++n) _Pragma("unroll") for (int k = 0; k < 2; ++k) dst[n][k] = *(const LAS bf16x8*)(lds + PG8_SB(b, h) + boff + n * 2048 + k * 1024); } while (0)
#define PG8_CAT(x) __builtin_bit_cast(i32x8, __builtin_shufflevector(__builtin_bit_cast(u32x4, (x)[0]), __builtin_bit_cast(u32x4, (x)[1]), 0, 1, 2, 3, 4, 5, 6, 7))
#define PG8_MMA(ai, bj, At, Bt) do { if (PROBE_VARIANT == 4 && Pb.probe_ && (ai) == 1) break; __builtin_amdgcn_s_setprio(1); \
        if constexpr (P::FP4) { _Pragma("unroll") for (int k = 0; k < 2; ++k) _Pragma("unroll") for (int m = 0; m < 4; ++m) _Pragma("unroll") for (int n = 0; n < 2; ++n) \
            asm volatile("v_mfma_scale_f32_16x16x128_f8f6f4 %0, %1, %2, %0, %3, %3 op_sel_hi:[0,0,0] cbsz:4 blgp:4" : "+v"(acc[ai][bj][m][n]) : "v"(Bt[n][k]), "v"(At[m][k]), "v"(mx_one)); } \
        else if constexpr (P::FP8) { _Pragma("unroll") for (int m = 0; m < 4; ++m) _Pragma("unroll") for (int n = 0; n < 2; ++n) \
            asm volatile("v_mfma_scale_f32_16x16x128_f8f6f4 %0, %1, %2, %0, %3, %3 op_sel_hi:[0,0,0]" : "+v"(acc[ai][bj][m][n]) : "v"(PG8_CAT(Bt[n])), "v"(PG8_CAT(At[m])), "v"(mx_one)); } \
        else { _Pragma("unroll") for (int m = 0; m < 4; ++m) _Pragma("unroll") for (int n = 0; n < 2; ++n) _Pragma("unroll") for (int k = 0; k < 2; ++k) \
            acc[ai][bj][m][n] = __builtin_amdgcn_mfma_f32_16x16x32_bf16(Bt[n][k], At[m][k], acc[ai][bj][m][n], 0, 0, 0); } \
        __builtin_amdgcn_s_setprio(0); } while (0)
#define PG8_WAIT_V(n) asm volatile("s_waitcnt vmcnt(" #n ")" ::: "memory")
#define PG8_WAIT_L(n) asm volatile("s_waitcnt lgkmcnt(" #n ")" ::: "memory")
#define PG8_BAR __builtin_amdgcn_s_barrier()
#define PG8_SCHED __builtin_amdgcn_sched_barrier(0)
    const unsigned mx_one = 0x7f7f7f7fu; (void)mx_one;
    GUnit cur, nxt; int ui = 0;
    if (!Pb.next(0, cur)) return;
    unsigned gC0[2] = {0u, 0u}, gC1[2] = {0u, 0u}, gN0[2] = {0u, 0u}, gN1[2] = {0u, 0u};
    if constexpr (P::GATHER) { Pb.gather(cur, RA, CA, gC0, gC1); }
    f32x4 acc[2][2][4][2]; float zz = 0.f; asm volatile("" : "+v"(zz));
#pragma unroll
    for (int a = 0; a < 2; ++a)
#pragma unroll
        for (int b = 0; b < 2; ++b)
#pragma unroll
            for (int m = 0; m < 4; ++m)
#pragma unroll
                for (int n = 0; n < 2; ++n) acc[a][b][m][n] = (f32x4){zz, zz, zz, zz};
    bf16x8 At[4][2], B0[2][2], B1[2][2];
    const char* cA = cur.A; const char* cB = cur.B;
#define PG8_STAGE_A(bufoff, kptr, h, o0, o1) do { if constexpr (P::GATHER) { if ((h) == 0) PG8_STAGE(bufoff, kptr, o0); else PG8_STAGE(bufoff, kptr, o1); } \
        else { PG8_STAGE(bufoff, (kptr) + (h) * hstepA, voffA); } } while (0)
    PG8_STAGE(PG8_SB(0, 0), cB, voffB); PG8_STAGE(PG8_SB(0, 1), cB + hstepB, voffB); PG8_STAGE_A(PG8_SA(0, 0), cA, 0, gC0, gC1); PG8_STAGE_A(PG8_SA(0, 1), cA, 1, gC0, gC1);
    if (wr == 1) PG8_BAR;
    PG8_WAIT_V(2); PG8_BAR;
    PG8_STAGE(PG8_SB(1, 0), cB + kstep, voffB); PG8_STAGE_A(PG8_SA(1, 0), cA + kstep, 0, gC0, gC1); PG8_STAGE(PG8_SB(1, 1), cB + hstepB + kstep, voffB);
    PG8_WAIT_V(6); PG8_BAR;
    for (;;) {
        const bool has_next = Pb.next(ui + 1, nxt);
        if constexpr (P::GATHER) { if (has_next) Pb.gather_issue(nxt, RA, (LAS unsigned*)(lds + STAGE_BYTES + wid * 1024)); }
        if constexpr (P::RELAX == 2) { if (wid == 0) { int l_ = lane; asm volatile("" : "+v"(l_)); Pb.bias_issue(cur, l_); } }
        const char* nA = has_next ? nxt.A : cA; const char* nB = has_next ? nxt.B : cB;
        int nt = cur.nt; asm volatile("" : "+s"(nt));
        for (int t = 0; t < nt; t += 2) {
            const bool last = (t == nt - 2);
            const bool fresh = P::RELAX && t == 0 && ui > 0;
            const char* a1 = cA + (size_t)(t + 1) * kstep;
            const char* a2 = last ? nA : cA + (size_t)(t + 2) * kstep; const char* b2 = last ? nB : cB + (size_t)(t + 2) * kstep;
            const char* a3 = a2 + kstep; const char* b3 = b2 + kstep;
            unsigned s0[2], s1[2];
            { const bool usen = last && has_next;
              if constexpr (P::GATHER) { if (usen) { const LAS unsigned* gs = (const LAS unsigned*)(lds + STAGE_BYTES + wid * 1024) + lane;
                  gN0[0] = gs[0] * lda + (unsigned)CA[0] * 2u; gN1[0] = gs[64] * lda + (unsigned)CA[0] * 2u; gN0[1] = gs[128] * lda + (unsigned)CA[1] * 2u; gN1[1] = gs[192] * lda + (unsigned)CA[1] * 2u; } }
              s0[0] = usen ? gN0[0] : gC0[0]; s0[1] = usen ? gN0[1] : gC0[1]; s1[0] = usen ? gN1[0] : gC1[0]; s1[1] = usen ? gN1[1] : gC1[1]; }
            PG8_LDB(B0, 0, 0); PG8_LDB(B1, 0, 1); PG8_SCHED; PG8_LDA(At, 0, 0); if (!fresh) { PG8_STAGE_A(PG8_SA(1, 1), a1, 1, gC0, gC1); PG8_WAIT_V(8); } else if (P::RELAX == 2) PG8_WAIT_V(16);
            PG8_WAIT_L(0); PG8_BAR; PG8_MMA(0, 0, At, B0); PG8_MMA(0, 1, At, B1); PG8_BAR; PG8_SCHED;
            PG8_LDA(At, 0, 1); PG8_STAGE(PG8_SB(0, 0), b2, voffB); PG8_STAGE(PG8_SB(0, 1), b2 + hstepB, voffB); PG8_STAGE_A(PG8_SA(0, 0), a2, 0, s0, s1);
            if (!fresh) PG8_WAIT_V(8); else if (P::RELAX == 2) PG8_WAIT_V(16);
            PG8_WAIT_L(0); PG8_BAR; PG8_MMA(1, 0, At, B0); PG8_MMA(1, 1, At, B1); PG8_BAR; PG8_SCHED;
            PG8_LDB(B0, 1, 0); PG8_LDB(B1, 1, 1); PG8_SCHED; PG8_LDA(At, 1, 0); PG8_STAGE_A(PG8_SA(0, 1), a2, 1, s0, s1);
            if (!fresh) PG8_WAIT_V(8); else if (P::RELAX == 16 || P::RELAX == 2) PG8_WAIT_V(16); else if (P::RELAX == 24) PG8_WAIT_V(24);
            PG8_WAIT_L(0); PG8_BAR; PG8_MMA(0, 0, At, B0); PG8_MMA(0, 1, At, B1); PG8_BAR; PG8_SCHED;
            PG8_LDA(At, 1, 1); PG8_STAGE(PG8_SB(1, 0), b3, voffB); PG8_STAGE(PG8_SB(1, 1), b3 + hstepB, voffB); PG8_STAGE_A(PG8_SA(1, 0), a3, 0, s0, s1);
            PG8_WAIT_V(8); PG8_WAIT_L(0); PG8_BAR; PG8_MMA(1, 0, At, B0); PG8_MMA(1, 1, At, B1); PG8_BAR; PG8_SCHED;
        }
        if (wr == 0) PG8_BAR;
        auto hoist = [&]() { if constexpr (P::RELAX != 0) { asm volatile("" ::: "memory"); if (has_next) { PG8_STAGE_A(PG8_SA(1, 1), nA + kstep, 1, gN0, gN1); } asm volatile("" ::: "memory"); } };
        if constexpr (P::FP8 || P::FP4) asm volatile("s_nop 15\n\ts_nop 15" ::: "memory");
        { int fr_ = fr, fq_ = fq, wr_ = wr, wc_ = wc; asm volatile("" : "+v"(fr_), "+v"(fq_)); asm volatile("" : "+s"(wr_), "+s"(wc_));
          Pb.epi(acc, cur, wr_, wc_, fr_, fq_, hoist); }
        if (!has_next) break;
        if (!nxt.keep) {
#pragma unroll
            for (int a = 0; a < 2; ++a)
#pragma unroll
                for (int b = 0; b < 2; ++b)
#pragma unroll
                    for (int m = 0; m < 4; ++m)
#pragma unroll
                        for (int n = 0; n < 2; ++n) acc[a][b][m][n] = (f32x4){0.f, 0.f, 0.f, 0.f};
        }
        cur = nxt; cA = nA; cB = nB; ++ui;
        if constexpr (P::GATHER) { gC0[0] = gN0[0]; gC0[1] = gN0[1]; gC1[0] = gN1[0]; gC1[1] = gN1[1]; }
        if (wr == 1) PG8_BAR;
    }
    PG8_WAIT_V(0);
    PG8_BAR;
#undef PG8_SA
#undef PG8_SB
#undef PG8_STAGE
#undef PG8_STAGE_A
#undef PG8_LDA
#undef PG8_LDB
#undef PG8_MMA
#undef PG8_CAT
#undef PG8_WAIT_V
#undef PG8_WAIT_L
#undef PG8_BAR
#undef PG8_SCHED
}
}
using pg8::GUnit;

struct Frame {
    LAS unsigned char* lds;
    volatile LAS unsigned* MISC;
    unsigned* ctl;
    int tid, lane, wave, vcu, G;
    unsigned char* ws;
};
struct Args { const float* in[28]; float* out; unsigned char* ws; int ph_lo, ph_hi; };

__device__ __forceinline__ int glu_rowmap(int s) { const int part = s >> 9, o = s & 511; return 256 * (o >> 7) + 64 * ((o >> 5) & 3) + 16 * ((o >> 3) & 3) + 8 * part + (o & 7); }
__device__ __forceinline__ void p0_transpose_item_fp8(const float* W, int K, int N, int ldw, unsigned char* WT, LAS float* scr, int item, int lane) {
    const int nblk = N / 32, kb = item / nblk, nb = item % nblk, k0 = 64 * kb, n0 = 32 * nb;
#pragma unroll
    for (int i = 0; i < 32; ++i) { const int kk = 2 * i + (lane >> 5); scr[kk * 33 + (lane & 31)] = W[(size_t)(k0 + kk) * ldw + n0 + (lane & 31)]; }
    LDS_WAIT(); asm volatile("" ::: "memory");
    const int c = lane & 7;
#pragma unroll
    for (int j = 0; j < 4; ++j) { const int n = (lane >> 3) + 8 * j; const LAS float* sp = scr + (8 * c) * 33 + n;
        u32x2 o; o.x = pk_fp8x4(sp[0 * 33] * FP8_SW, sp[1 * 33] * FP8_SW, sp[2 * 33] * FP8_SW, sp[3 * 33] * FP8_SW); o.y = pk_fp8x4(sp[4 * 33] * FP8_SW, sp[5 * 33] * FP8_SW, sp[6 * 33] * FP8_SW, sp[7 * 33] * FP8_SW);
        *(u32x2*)(WT + (size_t)(n0 + n) * K + k0 + 8 * c) = o; }
    LDS_WAIT(); asm volatile("" ::: "memory");
}
__device__ __forceinline__ void p0_transpose_item(const float* W, int K, int N, int ldw, bf16* WT, int glu, LAS float* scr, int item, int lane) {
    const int nblk = N / 32, kb = item / nblk, nb = item % nblk, k0 = 64 * kb, n0 = 32 * nb;
#pragma unroll
    for (int i = 0; i < 32; ++i) { const int kk = 2 * i + (lane >> 5); scr[kk * 33 + (lane & 31)] = W[(size_t)(k0 + kk) * ldw + n0 + (lane & 31)]; }
    LDS_WAIT(); asm volatile("" ::: "memory");
    const int c = lane & 7;
#pragma unroll
    for (int j = 0; j < 4; ++j) { const int n = (lane >> 3) + 8 * j; const LAS float* s = scr + (8 * c) * 33 + n;
        u32x4 o; o.x = pk2(s[0 * 33], s[1 * 33]); o.y = pk2(s[2 * 33], s[3 * 33]); o.z = pk2(s[4 * 33], s[5 * 33]); o.w = pk2(s[6 * 33], s[7 * 33]);
        const int nr = glu ? glu_rowmap(n0 + n) : (n0 + n);
        *(u32x4*)(WT + (size_t)nr * K + k0 + 8 * c) = o; }
    LDS_WAIT(); asm volatile("" ::: "memory");
}
__device__ __forceinline__ void ln_row_load(const float* xrow, int lane, f32x4 (&v)[8]) {
#pragma unroll
    for (int j = 0; j < 4; ++j) { const f32x4* p = (const f32x4*)(xrow + 8 * lane + 512 * j); v[2 * j] = p[0]; v[2 * j + 1] = p[1]; }
}
__device__ __forceinline__ void ln_row_v(f32x4 (&v)[8], const float* g, const float* b, float* o32, bf16* o16, int lane, float pre_scale, const f32x4* addv, unsigned char* o8 = nullptr, unsigned char* o4 = nullptr) {
    float s = 0.f;
#pragma unroll
    for (int j = 0; j < 8; ++j) { v[j] = v[j] * pre_scale; if (addv) v[j] += addv[j]; s += (v[j][0] + v[j][1]) + (v[j][2] + v[j][3]); }
    const float mean = wave_sum(s, lane) * (1.f / D); float s2 = 0.f;
#pragma unroll
    for (int j = 0; j < 8; ++j) { v[j] = v[j] - mean; s2 += (v[j][0] * v[j][0] + v[j][1] * v[j][1]) + (v[j][2] * v[j][2] + v[j][3] * v[j][3]); }
    const float rstd = 1.f / sqrtf(wave_sum(s2, lane) * (1.f / D) + LN_EPS);
#pragma unroll
    for (int j = 0; j < 4; ++j) { const int c = 8 * lane + 512 * j; const f32x4 g0 = *(const f32x4*)(g + c), g1 = *(const f32x4*)(g + c + 4), b0 = *(const f32x4*)(b + c), b1 = *(const f32x4*)(b + c + 4);
        const f32x4 y0 = v[2 * j] * rstd * g0 + b0, y1 = v[2 * j + 1] * rstd * g1 + b1;
        if (o32) { *(f32x4*)(o32 + c) = y0; *(f32x4*)(o32 + c + 4) = y1; }
        if (o16) *(u32x4*)(o16 + c) = pack8(y0, y1);
        if (o8) { u32x2 q8; q8.x = pk_fp8x4(y0[0] * FP8_SA, y0[1] * FP8_SA, y0[2] * FP8_SA, y0[3] * FP8_SA); q8.y = pk_fp8x4(y1[0] * FP8_SA, y1[1] * FP8_SA, y1[2] * FP8_SA, y1[3] * FP8_SA); *(u32x2*)(o8 + c) = q8; }
        if (o4) *(unsigned*)(o4 + (c >> 1)) = pk_fp4x8(y0, y1, FP4_SA); }
}

__device__ __forceinline__ void ssm_tables(Frame& F, const Args& a, int l, int g) {
    LAS f32x2* Pw = (LAS f32x2*)(F.lds);
    LAS f32x2* bb = (LAS f32x2*)(F.lds + 33 * 64 * 8);
    LAS f32x2* Cc = (LAS f32x2*)(F.lds + 33 * 64 * 8 + 8192);
    LAS float* Mt = (LAS float*)(F.lds + 33 * 64 * 8 + 16384);
    const int tid = F.tid, lg = l * 32 + g;
    const float* lre = a.in[6] + lg * 64; const float* lim = a.in[7] + lg * 64; const float ldt = a.in[8][lg];
    const float* bre = a.in[9] + (size_t)lg * 1024; const float* bim = a.in[10] + (size_t)lg * 1024;
    const float* cre = a.in[11] + (size_t)lg * 1024; const float* cim = a.in[12] + (size_t)lg * 1024;
    const float* dsk = a.in[13] + lg * 16;
    const float dt = expf(ldt);
    if (tid < 64) {
        const int p = tid; const float ar = lre[p] * dt, th = lim[p] * dt;
        for (int d = 0; d <= 32; ++d) { const float mag = expf(ar * (float)d); float sn, cs; sincosf(th * (float)d, &sn, &cs); Pw[d * 64 + p] = (f32x2){mag * cs, mag * sn}; }
    }
    __syncthreads();
    for (int i = tid; i < 1024; i += NTHR) {
        const int p = i >> 4, h = i & 15; const f32x2 lb = Pw[64 + p]; const float lr = lre[p], li = lim[p];
        const float nr = lb[0] - 1.f, ni = lb[1], den = lr * lr + li * li; const float fr = (nr * lr + ni * li) / den, fi = (ni * lr - nr * li) / den;
        const float br = bre[p * 16 + h], bi = bim[p * 16 + h]; bb[p * 16 + h] = (f32x2){fr * br - fi * bi, fr * bi + fi * br};
        const int h2 = i >> 6, p2 = i & 63; Cc[h2 * 64 + p2] = (f32x2){cre[h2 * 64 + p2], cim[h2 * 64 + p2]};
    }
    __syncthreads();
    { const int d = tid >> 4, ho = tid & 15; float accm[16];
#pragma unroll
      for (int hi = 0; hi < 16; ++hi) accm[hi] = 0.f;
      for (int p = 0; p < 64; ++p) { const f32x2 c = Cc[ho * 64 + p], w = Pw[d * 64 + p]; const float cr = c[0] * w[0] - c[1] * w[1], ci = c[0] * w[1] + c[1] * w[0];
#pragma unroll
          for (int hi = 0; hi < 16; ++hi) { const f32x2 b = bb[p * 16 + hi]; accm[hi] += cr * b[0] - ci * b[1]; } }
      if (d == 0) accm[ho] += dsk[ho];
#pragma unroll
      for (int hi = 0; hi < 16; ++hi) Mt[(d * 16 + ho) * 16 + hi] = accm[hi]; }
    __syncthreads();
    bf16* W1 = (bf16*)(F.ws + WS_W1S) + (size_t)lg * 512 * UK;
    for (int ch = tid; ch < 512 * (UK / 8); ch += NTHR) {
        const int n = ch / (UK / 8), k = (ch % (UK / 8)) * 8, t = n >> 4, ho = n & 15; float v[8];
        if (k < 512) { const int j = k >> 4, hi0 = k & 15;
#pragma unroll
            for (int i = 0; i < 8; ++i) v[i] = (t >= j) ? Mt[((t - j) * 16 + ho) * 16 + hi0 + i] : 0.f; }
        else { const int pp = k - 512; const bool im = pp >= 64; const int p0 = pp & 63;
#pragma unroll
            for (int i = 0; i < 8; ++i) { const f32x2 c = Cc[ho * 64 + p0 + i], w = Pw[(t + 1) * 64 + p0 + i]; v[i] = im ? -(c[0] * w[1] + c[1] * w[0]) : (c[0] * w[0] - c[1] * w[1]); } }
        u32x4 o; o.x = pk2(v[0], v[1]); o.y = pk2(v[2], v[3]); o.z = pk2(v[4], v[5]); o.w = pk2(v[6], v[7]);
        *(u32x4*)(W1 + (size_t)n * UK + k) = o;
    }
    bf16* Wst = (bf16*)(F.ws + WS_WST) + (size_t)lg * 256 * 512;
    for (int ch = tid; ch < 256 * 64; ch += NTHR) {
        const int n = ch >> 6, k = (ch & 63) * 8, j = k >> 4, hi0 = k & 15; float v[8];
        if (n < 128) { const int p = n & 63; const bool im = n >= 64; const f32x2 w = Pw[(31 - j) * 64 + p];
#pragma unroll
            for (int i = 0; i < 8; ++i) { const f32x2 b = bb[p * 16 + hi0 + i]; v[i] = im ? (w[0] * b[1] + w[1] * b[0]) : (w[0] * b[0] - w[1] * b[1]); } }
        else {
#pragma unroll
            for (int i = 0; i < 8; ++i) v[i] = 0.f; }
        u32x4 o; o.x = pk2(v[0], v[1]); o.y = pk2(v[2], v[3]); o.z = pk2(v[4], v[5]); o.w = pk2(v[6], v[7]);
        *(u32x4*)(Wst + (size_t)n * 512 + k) = o;
    }
    if (tid < 64) ((f32x2*)(F.ws + WS_LAM))[lg * 64 + tid] = Pw[32 * 64 + tid];
    __syncthreads();
}

struct TItem { const float* W; unsigned char* WT; int K, ldw, fp4; };
constexpr int TI_INA = (D / 128) * (2304 / 32), TI_ING = (D / 128) * (6144 / 32), TI_IN = TI_INA + TI_ING, TI_MKV = (D / 128) * (1024 / 32), TI_SQ = (D / 128) * (D / 32), TI_DN = (DFF / 128) * (D / 32);
__host__ __device__ constexpr int t_count(int grp) { return grp == 0 ? TI_INA + 2 * TI_MKV + 2 * TI_SQ : (grp == 1 ? 32 * TI_SQ : (grp == 2 ? 32 * TI_DN + TI_INA + 2 * TI_SQ + 32 * TI_SQ + 32 * TI_DN : 2 * TI_ING)); }
__device__ __forceinline__ TItem t_decode(const Args& a, unsigned char* ws, int grp, int it) {
    const float* W; unsigned char* WT; int K, N, ldw, r, fp4 = 0;
#define T_CLS(cnt_, ipm_, src_, dst_, K_, N_, ld_, bt0_) if (it < (cnt_)) { const int bt = it / (ipm_) + (bt0_); r = it % (ipm_); K = (K_); N = (N_); ldw = (ld_); W = (src_) + (size_t)bt * K * ldw; WT = ws + (dst_) + (size_t)bt * N * K; goto t_done; } it -= (cnt_);
    if (grp == 3) { const int bt = it / TI_ING; r = it % TI_ING; K = D; N = 6144; ldw = INW; W = a.in[4] + (size_t)bt * D * INW + 2304; WT = ws + WS_WIN4 + (size_t)bt * 6144 * (D / 2); fp4 = 1; goto t_done; }
    if (grp == 0) {
        if (it < TI_INA) { r = it; K = D; N = 2304; ldw = INW; W = a.in[4]; WT = ws + WS_WIN; goto t_done; } it -= TI_INA;
        T_CLS(2 * TI_MKV, TI_MKV, a.in[15], WS_WMKV, D, 1024, 1024, 0)
        T_CLS(TI_SQ, TI_SQ, a.in[16], WS_WBR, D, D, D, 0)
        T_CLS(TI_SQ, TI_SQ, a.in[17], WS_WOUT, D, D, D, 0)
    } else if (grp == 1) {
        T_CLS(32 * TI_SQ, TI_SQ, a.in[22], WS_WUP, D, D, D, 0)
    } else {
        T_CLS(32 * TI_DN, TI_DN, a.in[24], WS_WDN, DFF, D, D, 0)
        if (it < TI_INA) { r = it; K = D; N = 2304; ldw = INW; W = a.in[4] + (size_t)D * INW; WT = ws + WS_WIN + (size_t)INW * D; goto t_done; } it -= TI_INA;
        T_CLS(TI_SQ, TI_SQ, a.in[16], WS_WBR, D, D, D, 1)
        T_CLS(TI_SQ, TI_SQ, a.in[17], WS_WOUT, D, D, D, 1)
        T_CLS(32 * TI_SQ, TI_SQ, a.in[22], WS_WUP, D, D, D, 32)
        T_CLS(32 * TI_DN, TI_DN, a.in[24], WS_WDN, DFF, D, D, 32)
    }
    W = a.in[4]; WT = ws + WS_WIN; K = D; N = INW; ldw = INW; r = 0;
t_done:
#undef T_CLS
    const int nblk = N / 32, kb = r / nblk, nb = r % nblk;
    TItem t; t.W = W + (size_t)(128 * kb) * ldw + 32 * nb; t.fp4 = fp4; t.K = fp4 ? K / 2 : K; t.WT = WT + (size_t)(32 * nb) * t.K + (fp4 ? 64 * kb : 128 * kb); t.ldw = ldw; return t;
}
template <bool NT> __device__ __forceinline__ void t_load(const TItem& t, float (&v)[64], int lane) {
    int ld = t.ldw; asm volatile("" : "+s"(ld));
    const float* p = t.W + (size_t)(lane >> 5) * ld + (lane & 31);
#pragma unroll
    for (int i = 0; i < 64; ++i) v[i] = NT ? __builtin_nontemporal_load(p + (size_t)(2 * i) * ld) : p[(size_t)(2 * i) * ld];
}
template <bool NTS = false, bool F4 = false> __device__ __forceinline__ void t_finish(const TItem& t, const float (&v)[64], LAS float* scr, int lane) {
#pragma unroll
    for (int i = 0; i < 64; ++i) { const int kk = 2 * i + (lane >> 5); scr[kk * 32 + (((lane & 31) + 2 * (kk >> 3)) & 31)] = v[i]; }
    LDS_WAIT(); asm volatile("" ::: "memory");
    const int c = lane & 15;
#pragma unroll
    for (int j = 0; j < 8; ++j) { const int n = (lane >> 4) + 4 * j; const LAS float* sp = scr + (8 * c) * 32 + ((n + 2 * c) & 31);
        if constexpr (F4) { const unsigned o4 = pk_fp4x8((f32x4){sp[0], sp[32], sp[64], sp[96]}, (f32x4){sp[128], sp[160], sp[192], sp[224]}, FP4_SW);
            if (NTS) __builtin_nontemporal_store(o4, (unsigned*)(t.WT + (size_t)n * t.K + 4 * c)); else *(unsigned*)(t.WT + (size_t)n * t.K + 4 * c) = o4; continue; }
        u32x2 o; o.x = pk_fp8x4(sp[0] * FP8_SW, sp[32] * FP8_SW, sp[64] * FP8_SW, sp[96] * FP8_SW); o.y = pk_fp8x4(sp[128] * FP8_SW, sp[160] * FP8_SW, sp[192] * FP8_SW, sp[224] * FP8_SW);
        if (NTS) __builtin_nontemporal_store(o, (u32x2*)(t.WT + (size_t)n * t.K + 8 * c)); else *(u32x2*)(t.WT + (size_t)n * t.K + 8 * c) = o; }
    LDS_WAIT(); asm volatile("" ::: "memory");
}
template <bool NT, bool F4 = false> __device__ __forceinline__ void t_run(Frame& F, const Args& a, int grp, int gw, int NGW, int n1 = 1 << 30, int w2 = -1, int NW2 = 1) {
    int lane = F.lane; asm volatile("" : "+s"(gw)); asm volatile("" : "+v"(lane));
    LAS float* scr = (LAS float*)(F.lds + F.wave * 16384); const int n = t_count(grp); if (n1 > n) n1 = n;
#define T_NEXT(i) (((i) < n1) ? (((i) + NGW < n1) ? (i) + NGW : ((w2 >= 0) ? n1 + w2 : n)) : (i) + NW2)
    float va[64], vb[64]; int it = (gw < n1) ? gw : ((w2 >= 0) ? n1 + w2 : n); TItem cur, nxt;
    if (it < n) { cur = t_decode(a, F.ws, grp, it); t_load<NT>(cur, va, lane); }
    while (it < n) {
        const int nit = T_NEXT(it); const bool hn = nit < n;
        if (hn) { nxt = t_decode(a, F.ws, grp, nit); t_load<NT>(nxt, vb, lane); }
        t_finish<NT, F4>(cur, va, scr, lane);
        if (hn) { cur = nxt;
#pragma unroll
            for (int i = 0; i < 64; ++i) va[i] = vb[i]; }
        it = nit; }
#undef T_NEXT
}
__device__ __forceinline__ void p0_prologue(Frame& F, const Args& a) {
    if (blockIdx.x < 64) ssm_tables(F, a, blockIdx.x >> 5, blockIdx.x & 31);
    LAS float* scr = (LAS float*)(F.lds + F.wave * 16384);
    const int gw = F.vcu * NWAVES + F.wave, NGW = F.G * NWAVES;
    t_run<false>(F, a, 0, gw, NGW);
    t_run<false, true>(F, a, 3, gw, NGW);
    { const int nbusy = (F.G > 64) ? 64 : 0, NW2 = (F.G - nbusy) * NWAVES, w2 = ((int)blockIdx.x >= nbusy) ? ((int)blockIdx.x - nbusy) * NWAVES + F.wave : -1;
      const int n1 = nbusy ? t_count(1) - 5 * NW2 : t_count(1);
      t_run<false>(F, a, 1, gw, NGW, n1 > 0 ? n1 : t_count(1), w2, NW2); }
    { constexpr int I_GLU = (512 / 64) * (1024 / 32);
      for (int it = gw; it < 2 * I_GLU; it += NGW) { const int bt = it / I_GLU, r = it % I_GLU; p0_transpose_item(a.in[14] + (size_t)bt * 512 * 1024, 512, 1024, 1024, (bf16*)(F.ws + WS_WGLU) + (size_t)bt * 1024 * 512, 1, scr, r, F.lane); } }
    { int m = gw; f32x4 xv[8], nx[8]; if (m < T) ln_row_load(a.in[0] + (size_t)m * D, F.lane, xv);
      for (; m < T; m += NGW) { const int mn = (m + NGW < T) ? m + NGW : m; ln_row_load(a.in[0] + (size_t)mn * D, F.lane, nx); asm volatile("" ::: "memory");
          ln_row_v(xv, a.in[2], a.in[3], nullptr, (bf16*)(F.ws + WS_HB) + (size_t)m * D, F.lane, 1.f, nullptr, (unsigned char*)(F.ws + WS_H8) + (size_t)m * D, (unsigned char*)(F.ws + WS_H4) + (size_t)m * (D / 2));
#pragma unroll
          for (int j = 0; j < 8; ++j) xv[j] = nx[j]; } }
    { const size_t n8 = (size_t)4096 * D / 8; const f32x4* src = (const f32x4*)a.in[1]; u32x2* dst = (u32x2*)(F.ws + WS_MEMB);
      for (size_t i = (size_t)blockIdx.x * NTHR + F.tid; i < n8; i += (size_t)F.G * NTHR) { const f32x4 x0 = src[2 * i] * FP8_SA, x1 = src[2 * i + 1] * FP8_SA; u32x2 q8; q8.x = pk_fp8x4(x0[0], x0[1], x0[2], x0[3]); q8.y = pk_fp8x4(x1[0], x1[1], x1[2], x1[3]); dst[i] = q8; } }
    { bf16* wr = (bf16*)(F.ws + WS_WRT);
      for (int i = blockIdx.x * NTHR + F.tid; i < NL * NE * D; i += F.G * NTHR) { const int l = i / (NE * D), r = i % (NE * D), e = r / D, k = r % D;
          const float w = a.in[20][(size_t)l * D * NE + (size_t)k * NE + e]; const unsigned hi = pk2(w, 0.f) & 0xffffu; const float lo = w - bf2f((unsigned short)hi);
          wr[((size_t)(l * 2 + 0) * NE + e) * D + k] = (bf16)hi; wr[((size_t)(l * 2 + 1) * NE + e) * D + k] = (bf16)(pk2(lo, 0.f) & 0xffffu); } }
}

#define EPI_ARGS const f32x4 (&acc)[2][2][4][2], const GUnit& u, int wr, int wc, int fr, int fq, const HOIST& hoist
#define EPI_ROWS(...) _Pragma("unroll") for (int ai = 0; ai < 2; ++ai) _Pragma("unroll") for (int m = 0; m < 4; ++m) { const int lrow = ai * 128 + wr * 64 + m * 16 + fr, lcol = wc * 64 + fq * 16; \
        const f32x4 v0 = acc[ai][0][m][0], v1 = acc[ai][0][m][1], v2 = acc[ai][1][m][0], v3 = acc[ai][1][m][1]; __VA_ARGS__ }
__device__ __forceinline__ u32x4 pk_fp8x16(const f32x4 a, const f32x4 b, const f32x4 c, const f32x4 d, float sc) {
    u32x4 w; w.x = pk_fp8x4(a[0] * sc, a[1] * sc, a[2] * sc, a[3] * sc); w.y = pk_fp8x4(b[0] * sc, b[1] * sc, b[2] * sc, b[3] * sc); w.z = pk_fp8x4(c[0] * sc, c[1] * sc, c[2] * sc, c[3] * sc); w.w = pk_fp8x4(d[0] * sc, d[1] * sc, d[2] * sc, d[3] * sc); return w; }

__device__ __forceinline__ unsigned gate_u8x4(const f32x4 x, const float sc = FP8_DESCALE) { unsigned w = 0u;
    const float k = -sc * 1.4426950408889634f;
    const f32x2 t0 = (f32x2){x[0], x[1]} * k, t1 = (f32x2){x[2], x[3]} * k;
    const f32x2 e0 = (f32x2){__builtin_amdgcn_exp2f(t0[0]), __builtin_amdgcn_exp2f(t0[1])} + 1.0f, e1 = (f32x2){__builtin_amdgcn_exp2f(t1[0]), __builtin_amdgcn_exp2f(t1[1])} + 1.0f;
    const f32x2 q0 = (f32x2){__builtin_amdgcn_rcpf(e0[0]), __builtin_amdgcn_rcpf(e0[1])} * 256.0f - 0.5f, q1 = (f32x2){__builtin_amdgcn_rcpf(e1[0]), __builtin_amdgcn_rcpf(e1[1])} * 256.0f - 0.5f;
    w = __builtin_amdgcn_cvt_pk_u8_f32(q0[0], 0, w); w = __builtin_amdgcn_cvt_pk_u8_f32(q0[1], 1, w); w = __builtin_amdgcn_cvt_pk_u8_f32(q1[0], 2, w); w = __builtin_amdgcn_cvt_pk_u8_f32(q1[1], 3, w); return w; }
struct PInproj {
    static constexpr bool GATHER = false, FP8 = true, FP4 = false; static constexpr int RELAX = 0; unsigned lda, ldb; int probe_ = 0;
    const char *hb, *win, *memb, *wmkv; int G, c, nextra, mode, i0, i1;
    bf16 *q, *kv, *U, *qm, *mkv; unsigned char* gates;
    __device__ __forceinline__ bool next(int i, GUnit& u) const {
        if (i + i0 >= i1) return false;
        long L = (long)(i + i0) * G + c; int pm, pn;
        if (mode) { if (L >= 128 * 24) return false; pg8::tile_map((int)L, 128, 24, pm, pn); pn += 9; u.A = hb + (size_t)pm * 256 * 2048; u.B = win + (size_t)pn * 256 * 2048; u.nt = 16; u.keep = 0; u.pm = pm; u.pn = pn; u.aux = 0; return true; }
        if (L < 128 * 9) { pg8::tile_map((int)L, 128, 9, pm, pn); u.A = hb + (size_t)pm * 256 * 2048; u.B = win + (size_t)pn * 256 * 2048; u.nt = 16; u.keep = 0; u.pm = pm; u.pn = pn; u.aux = 0; return true; }
        L -= 128 * 9; if (L >= nextra) return false;
        pm = (int)L & 15; pn = (int)L >> 4; u.A = memb + (size_t)pm * 256 * 2048; u.B = wmkv + (size_t)pn * 256 * 2048; u.nt = 16; u.keep = 0; u.pm = pm; u.pn = pn; u.aux = 1; return true;
    }
    template <class HOIST> __device__ __forceinline__ void epi(EPI_ARGS) const {
        const int pn = u.pn, row0 = u.pm * 256, col0 = pn * 256;
        if (PROBE_VARIANT >= 3 && probe_) return;
#define ST_BF16x16(ptr, sc) do { bf16* p_ = (ptr); *(u32x4*)p_ = pack8(v0 * (sc), v1 * (sc)); *(u32x4*)(p_ + 8) = pack8(v2 * (sc), v3 * (sc)); } while (0)
        if (u.aux) { EPI_ROWS( ST_BF16x16(mkv + (size_t)(row0 + lrow) * 2048 + col0 + lcol, FP8_DESCALE); ) }
        else if (pn < 4) { EPI_ROWS( ST_BF16x16(q + (size_t)(row0 + lrow) * 1024 + col0 + lcol, 0.125f * 1.4426950408889634f * FP8_DESCALE); ) }
        else if (pn == 4) { EPI_ROWS( ST_BF16x16(kv + (size_t)(row0 + lrow) * 256 + lcol, FP8_DESCALE); ) }
        else if (pn < 7) { EPI_ROWS( const int ch = col0 - 1280 + lcol, g = ch >> 4, row = row0 + lrow, b = row >> 11, sq = row & 2047;
                                     ST_BF16x16(U + ((size_t)(g * 1024 + b * 64 + (sq >> 5))) * UK + (sq & 31) * 16, FP8_DESCALE); ) }
        else if (pn < 9) { EPI_ROWS( ST_BF16x16(qm + (size_t)(row0 + lrow) * 512 + col0 - 1792 + lcol, 0.08838834764831845f * 1.4426950408889634f * FP8_DESCALE); ) }
        else { EPI_ROWS( u32x4 w; w.x = gate_u8x4(v0); w.y = gate_u8x4(v1); w.z = gate_u8x4(v2); w.w = gate_u8x4(v3); *(u32x4*)(gates + (size_t)(row0 + lrow) * 6144 + col0 - 2304 + lcol) = w; ) }
    }
};

struct PInGate4 {
    static constexpr bool GATHER = false, FP8 = false, FP4 = true; static constexpr int RELAX = 0; unsigned lda, ldb; int probe_ = 0;
    const char *h4, *win4; int G, c; unsigned char* gates;
    __device__ __forceinline__ bool next(int i, GUnit& u) const {
        const long L = (long)i * G + c; if (L >= 128 * 24) return false; int pm, pn; pg8::tile_map((int)L, 128, 24, pm, pn);
        u.A = h4 + (size_t)pm * 256 * 1024; u.B = win4 + (size_t)pn * 256 * 1024; u.nt = 8; u.keep = 0; u.pm = pm; u.pn = pn; u.aux = 0; return true;
    }
    template <class HOIST> __device__ __forceinline__ void epi(EPI_ARGS) const {
        EPI_ROWS( u32x4 w; w.x = gate_u8x4(v0, FP4_DESCALE); w.y = gate_u8x4(v1, FP4_DESCALE); w.z = gate_u8x4(v2, FP4_DESCALE); w.w = gate_u8x4(v3, FP4_DESCALE);
                  *(u32x4*)(gates + (size_t)(u.pm * 256 + lrow) * 6144 + u.pn * 256 + lcol) = w; )
    }
};

struct PSsmState {
    static constexpr bool GATHER = false, FP8 = false, FP4 = false; static constexpr int RELAX = 0; unsigned lda, ldb; int probe_ = 0;
    const char *U, *Wst; int G, c; float* S;
    __device__ __forceinline__ bool next(int i, GUnit& u) const {
        const long L = (long)i * G + c; if (L >= 128) return false;
        const int g = (int)L >> 2, rt = (int)L & 3; u.A = U + ((size_t)g * 1024 + rt * 256) * (UK * 2); u.B = Wst + (size_t)g * 256 * 1024; u.nt = 8; u.keep = 0; u.pm = rt; u.pn = 0; u.aux = g; return true;
    }
    template <class HOIST> __device__ __forceinline__ void epi(EPI_ARGS) const {
        float* base = S + ((size_t)u.aux * 1024 + u.pm * 256) * 128;
        EPI_ROWS( if (wc < 2) { float* p = base + (size_t)lrow * 128 + lcol; *(f32x4*)p = v0; *(f32x4*)(p + 4) = v1; *(f32x4*)(p + 8) = v2; *(f32x4*)(p + 12) = v3; } )
    }
};

__device__ __forceinline__ float gelu_tanh(float x) { const float u2 = 1.5957691216057308f * (x + 0.044715f * x * x * x); return x * __builtin_amdgcn_rcpf(1.0f + __expf(-u2)); }
struct PSsmOut {
    static constexpr bool GATHER = false, FP8 = false, FP4 = false; static constexpr int RELAX = 0; unsigned lda, ldb; int probe_ = 0;
    const char *U, *W1; int G, c; bf16* z;
    __device__ __forceinline__ bool next(int i, GUnit& u) const {
        if (c >= 128 || i >= 2) return false;
        const int g = c >> 2, rt = c & 3, pn = i; u.A = U + ((size_t)g * 1024 + rt * 256) * (UK * 2); u.B = W1 + ((size_t)g * 512 + pn * 256) * (UK * 2); u.nt = 10; u.keep = 0; u.pm = rt; u.pn = pn; u.aux = g; return true;
    }
    template <class HOIST> __device__ __forceinline__ void epi(EPI_ARGS) const {
        const int g = u.aux;
        EPI_ROWS( const int row = u.pm * 256 + lrow, b = row >> 6, cc = row & 63, col = u.pn * 256 + lcol, t = col >> 4; f32x4 y0, y1, y2, y3;
                  _Pragma("unroll") for (int j = 0; j < 4; ++j) { y0[j] = gelu_tanh(v0[j]); y1[j] = gelu_tanh(v1[j]); y2[j] = gelu_tanh(v2[j]); y3[j] = gelu_tanh(v3[j]); }
                  bf16* zp = z + (size_t)(b * 2048 + cc * 32 + t) * 512 + g * 16; *(u32x4*)zp = pack8(y0, y1); *(u32x4*)(zp + 8) = pack8(y2, y3); )
    }
};

struct PGlu {
    static constexpr bool GATHER = false, FP8 = false, FP4 = false; static constexpr int RELAX = 0; unsigned lda, ldb; int probe_ = 0;
    const char *z, *wg; int G, c; unsigned char* mix;
    __device__ __forceinline__ bool next(int i, GUnit& u) const {
        const long L = (long)i * G + c; if (L >= 128 * 4) return false; int pm, pn; pg8::tile_map((int)L, 128, 4, pm, pn);
        u.A = z + (size_t)pm * 256 * 1024; u.B = wg + (size_t)pn * 256 * 1024; u.nt = 8; u.keep = 0; u.pm = pm; u.pn = pn; u.aux = 0; return true;
    }
    template <class HOIST> __device__ __forceinline__ void epi(EPI_ARGS) const {
        EPI_ROWS( const int o = 128 * u.pn + 32 * wc + 8 * fq; u32x2 w;
                  w.x = pk_fp8x4(v0[0] * fsigmoid(v2[0]) * FP8_SA, v0[1] * fsigmoid(v2[1]) * FP8_SA, v0[2] * fsigmoid(v2[2]) * FP8_SA, v0[3] * fsigmoid(v2[3]) * FP8_SA);
                  w.y = pk_fp8x4(v1[0] * fsigmoid(v3[0]) * FP8_SA, v1[1] * fsigmoid(v3[1]) * FP8_SA, v1[2] * fsigmoid(v3[2]) * FP8_SA, v1[3] * fsigmoid(v3[3]) * FP8_SA);
                  *(u32x2*)(mix + (size_t)(u.pm * 256 + lrow) * 2048 + 1024 + o) = w; (void)lcol; )
    }
};

__device__ __forceinline__ float ubf(unsigned w, int k) { return (float)((w >> (8 * k)) & 0xffu); }
struct PBranch {
    static constexpr bool GATHER = false, FP8 = true, FP4 = false; static constexpr int RELAX = 1; unsigned lda, ldb; int probe_ = 0;
    const char *mix, *wb; int G, c; const unsigned char* gates; unsigned char* mrg;
    __device__ __forceinline__ bool next(int i, GUnit& u) const {
        const int tile = (i / 3) * G + c, seg = i % 3; if (tile >= 128 * 8) return false; int pm, pn; pg8::tile_map(tile, 128, 8, pm, pn);
        const int koff = seg == 0 ? 0 : (seg == 1 ? 1024 : 1536);
        u.A = mix + (size_t)pm * 256 * 2048 + koff; u.B = wb + (size_t)pn * 256 * 2048 + koff; u.nt = seg == 0 ? 8 : 4; u.keep = seg != 0; u.pm = pm; u.pn = pn; u.aux = seg; return true;
    }
    template <class HOIST> __device__ __forceinline__ void epi(f32x4 (&acc)[2][2][4][2], const GUnit& u, int wr, int wc, int fr, int fq, const HOIST& hoist) const {
        const int seg = u.aux; const int so = seg < 2 ? seg * 2048 : 4096; hoist();
#pragma unroll
        for (int ai = 0; ai < 2; ++ai) {
            u32x4 ga[4], gb[4];
#pragma unroll
            for (int m = 0; m < 4; ++m) { const unsigned char* gp = gates + (size_t)(u.pm * 256 + ai * 128 + wr * 64 + m * 16 + fr) * 6144 + u.pn * 256 + wc * 64 + fq * 16 + so;
                ga[m] = *(const u32x4*)gp; gb[m] = (seg < 2) ? *(const u32x4*)(gp + 2048) : (u32x4){0u, 0u, 0u, 0u}; }
#pragma unroll
            for (int m = 0; m < 4; ++m) { const int row = u.pm * 256 + ai * 128 + wr * 64 + m * 16 + fr, col = u.pn * 256 + wc * 64 + fq * 16;
                if (seg < 2) {
#pragma unroll
                    for (int w4 = 0; w4 < 4; ++w4) { const unsigned a = ga[m][w4], b = gb[m][w4]; f32x4 r;
                        r[0] = (ubf(a, 0) + 0.5f) * __builtin_amdgcn_rcpf(ubf(b, 0) + 0.5f); r[1] = (ubf(a, 1) + 0.5f) * __builtin_amdgcn_rcpf(ubf(b, 1) + 0.5f);
                        r[2] = (ubf(a, 2) + 0.5f) * __builtin_amdgcn_rcpf(ubf(b, 2) + 0.5f); r[3] = (ubf(a, 3) + 0.5f) * __builtin_amdgcn_rcpf(ubf(b, 3) + 0.5f);
                        acc[ai][w4 >> 1][m][w4 & 1] *= r; } }
                else { f32x4 o[4];
#pragma unroll
                    for (int w4 = 0; w4 < 4; ++w4) { const unsigned a = ga[m][w4]; f32x4 r;
                        r[0] = ubf(a, 0) + 0.5f; r[1] = ubf(a, 1) + 0.5f; r[2] = ubf(a, 2) + 0.5f; r[3] = ubf(a, 3) + 0.5f;
                        o[w4] = acc[ai][w4 >> 1][m][w4 & 1] * r; }
                    *(u32x4*)(mrg + (size_t)row * 2048 + col) = pk_fp8x16(o[0], o[1], o[2], o[3], FP8_DESCALE * FP8_SA / 256.0f); } }
            asm volatile("" ::: "memory");
        }
    }
};

struct PWout {
    static constexpr bool GATHER = false, FP8 = true, FP4 = false; static constexpr int RELAX = 24; unsigned lda, ldb; int probe_ = 0;
    const char *mrg, *wo; int G, c; bf16* h;
    __device__ __forceinline__ bool next(int i, GUnit& u) const {
        const long L = (long)i * G + c; if (L >= 128 * 8) return false; int pm, pn; pg8::tile_map((int)L, 128, 8, pm, pn);
        u.A = mrg + (size_t)pm * 256 * 2048; u.B = wo + (size_t)pn * 256 * 2048; u.nt = 16; u.keep = 0; u.pm = pm; u.pn = pn; u.aux = 0; return true;
    }
    template <class HOIST> __device__ __forceinline__ void epi(EPI_ARGS) const {
        u32x4 hwv[2][4][2];
#pragma unroll
        for (int ai = 0; ai < 2; ++ai)
#pragma unroll
            for (int m = 0; m < 4; ++m) { const bf16* hp = h + (size_t)(u.pm * 256 + ai * 128 + wr * 64 + m * 16 + fr) * 2048 + u.pn * 256 + wc * 64 + fq * 16; hwv[ai][m][0] = *(const u32x4*)hp; hwv[ai][m][1] = *(const u32x4*)(hp + 8); }
        hoist();
        EPI_ROWS( bf16* p = h + (size_t)(u.pm * 256 + lrow) * 2048 + u.pn * 256 + lcol; const u32x4 ha = hwv[ai][m][0], hb2 = hwv[ai][m][1];
                  const f32x4 h0 = (f32x4){bflo(ha.x), bfhi(ha.x), bflo(ha.y), bfhi(ha.y)}, h1 = (f32x4){bflo(ha.z), bfhi(ha.z), bflo(ha.w), bfhi(ha.w)};
                  const f32x4 h2 = (f32x4){bflo(hb2.x), bfhi(hb2.x), bflo(hb2.y), bfhi(hb2.y)}, h3 = (f32x4){bflo(hb2.z), bfhi(hb2.z), bflo(hb2.w), bfhi(hb2.w)};
                  *(u32x4*)p = pack8(h0 * DN_ALPHA + v0 * FP8_DESCALE, h1 * DN_ALPHA + v1 * FP8_DESCALE); *(u32x4*)(p + 8) = pack8(h2 * DN_ALPHA + v2 * FP8_DESCALE, h3 * DN_ALPHA + v3 * FP8_DESCALE); )
    }
};

__device__ __forceinline__ void moe_tables(Frame& F, int l) {
    volatile LAS int* cnt = (volatile LAS int*)(F.lds + MISC_OFF + MO_CNT); volatile LAS int* tst = (volatile LAS int*)(F.lds + MISC_OFF + MO_TST);
    volatile LAS int* pnt = (volatile LAS int*)(F.lds + MISC_OFF + MO_NT); volatile LAS unsigned char* te = (volatile LAS unsigned char*)(F.lds + MISC_OFF + MO_TE);
    __syncthreads();
    if (F.tid < 32) cnt[F.tid] = (int)__hip_atomic_load(F.ctl + CW_CNT + (l * 32 + F.tid) * 64, RLX_AGENT);
    __syncthreads();
    if (F.tid == 0) { int s = 0; for (int e = 0; e < 32; ++e) { tst[e] = s; s += (cnt[e] + 255) >> 8; } tst[32] = s; pnt[0] = s; }
    __syncthreads();
    const int NT = pnt[0];
    for (int t = F.tid; t < NT; t += NTHR) { int e = 0; while (e < 31 && tst[e + 1] <= t) ++e; te[t] = (unsigned char)e; }
    __syncthreads();
}

struct PMoeUp {
    static constexpr bool GATHER = true, FP8 = true, FP4 = false; static constexpr int RELAX = 16; unsigned lda, ldb; int probe_ = 0;
    const char *hb, *wup; int G, c, i0, i1; const int* list; const float* bup; unsigned char* act; LAS unsigned char* misc;
    __device__ __forceinline__ bool next(int i, GUnit& u) const {
        if (i + i0 >= i1) return false;
        const int NT = __builtin_amdgcn_readfirstlane(*(volatile LAS int*)(misc + MO_NT)); const long L = (long)(i + i0) * G + c; if (L >= (long)NT * 8) return false; int pm, pn; pg8::tile_map((int)L, NT, 8, pm, pn);
        const int e = __builtin_amdgcn_readfirstlane((int)((volatile LAS unsigned char*)(misc + MO_TE))[pm]);
        u.A = hb; u.B = wup + ((size_t)e * 2048 + pn * 256) * 2048; u.nt = 16; u.keep = 0; u.pm = pm; u.pn = pn; u.aux = e; u.slot = i & 1; return true;
    }
    __device__ __forceinline__ void gather_issue(const GUnit& u, const int (&RA)[2], LAS unsigned* slot) const {
        const int e = u.aux, cnt = ((volatile LAS int*)(misc + MO_CNT))[e], base = (u.pm - ((volatile LAS int*)(misc + MO_TST))[e]) * 256;
#pragma unroll
        for (int i = 0; i < 2; ++i)
#pragma unroll
            for (int h = 0; h < 2; ++h) { int sl = base + h * 128 + RA[i]; sl = sl < cnt ? sl : cnt - 1;
                __builtin_amdgcn_global_load_lds((const unsigned*)(list + e * 32768 + sl), slot + (i * 2 + h) * 64, 4, 0, 0); }
    }
    __device__ __forceinline__ void bias_issue(const GUnit& u, int lane) const {
        __builtin_amdgcn_global_load_lds((const unsigned*)(bup + (size_t)u.aux * 2048 + u.pn * 256 + lane * 4), (LAS unsigned*)(misc + 4096 + u.slot * 1024), 16, 0, 0); }
    __device__ __forceinline__ void gather(const GUnit& u, const int (&RA)[2], const int (&CA)[2], unsigned (&g0)[2], unsigned (&g1)[2]) const {
        const int e = u.aux, cnt = ((volatile LAS int*)(misc + MO_CNT))[e], base = (u.pm - ((volatile LAS int*)(misc + MO_TST))[e]) * 256;
#pragma unroll
        for (int i = 0; i < 2; ++i) { const int s0 = base + RA[i], s1 = s0 + 128;
            const int t0 = s0 < cnt ? list[e * 32768 + s0] : 0, t1 = s1 < cnt ? list[e * 32768 + s1] : 0;
            g0[i] = (unsigned)t0 * 2048u + (unsigned)CA[i] * 2u; g1[i] = (unsigned)t1 * 2048u + (unsigned)CA[i] * 2u; }
    }
    template <class HOIST> __device__ __forceinline__ void epi(EPI_ARGS) const {
        f32x4 bv[4];
        if constexpr (RELAX == 2) { hoist(); const LAS float* bias = (const LAS float*)(misc + 4096 + u.slot * 1024) + wc * 64 + 16 * fq;
#pragma unroll
            for (int j = 0; j < 4; ++j) bv[j] = *(const LAS f32x4*)(bias + 4 * j); }
        else { const float* bias = bup + (size_t)u.aux * 2048 + u.pn * 256 + wc * 64 + 16 * fq;
#pragma unroll
            for (int j = 0; j < 4; ++j) bv[j] = *(const f32x4*)(bias + 4 * j);
            hoist(); }
        EPI_ROWS( const f32x4 x[4] = {v0 * FP8_DESCALE + bv[0], v1 * FP8_DESCALE + bv[1], v2 * FP8_DESCALE + bv[2], v3 * FP8_DESCALE + bv[3]}; f32x2 r[4];
                  _Pragma("unroll") for (int k = 0; k < 4; ++k) {
                      const f32x2 gl = (f32x2){fminf(x[k][0], 7.0f), fminf(x[k][2], 7.0f)}, ln = (f32x2){fminf(fmaxf(x[k][1], -7.0f), 7.0f), fminf(fmaxf(x[k][3], -7.0f), 7.0f)};
                      const f32x2 t = gl * (-1.702f * 1.4426950408889634f);
                      const f32x2 e = (f32x2){__builtin_amdgcn_exp2f(t[0]), __builtin_amdgcn_exp2f(t[1])} + 1.0f;
                      const f32x2 sg = (f32x2){__builtin_amdgcn_rcpf(e[0]), __builtin_amdgcn_rcpf(e[1])};
                      r[k] = (gl * sg) * (ln * FP8_SA + FP8_SA); }
                  u32x2 w; w.x = __builtin_amdgcn_cvt_pk_fp8_f32(r[0][0], r[0][1], 0u, false); w.x = __builtin_amdgcn_cvt_pk_fp8_f32(r[1][0], r[1][1], w.x, true);
                  w.y = __builtin_amdgcn_cvt_pk_fp8_f32(r[2][0], r[2][1], 0u, false); w.y = __builtin_amdgcn_cvt_pk_fp8_f32(r[3][0], r[3][1], w.y, true);
                  *(u32x2*)(act + (size_t)(u.pm * 256 + lrow) * 1024 + u.pn * 128 + (lcol >> 1)) = w; )
    }
};
struct PMoeDown {
    static constexpr bool GATHER = false, FP8 = true, FP4 = false; static constexpr int RELAX = 2; unsigned lda, ldb; int probe_ = 0;
    const char *act, *wdn; int G, c; const float* bdn; unsigned char* op; LAS unsigned char* misc;
    __device__ __forceinline__ bool next(int i, GUnit& u) const {
        const int NT = __builtin_amdgcn_readfirstlane(*(volatile LAS int*)(misc + MO_NT)); const long L = (long)i * G + c; if (L >= (long)NT * 8) return false; int pm, pn; pg8::tile_map((int)L, NT, 8, pm, pn);
        const int e = __builtin_amdgcn_readfirstlane((int)((volatile LAS unsigned char*)(misc + MO_TE))[pm]);
        u.A = act + (size_t)pm * 256 * 1024; u.B = wdn + ((size_t)e * 2048 + pn * 256) * 1024; u.nt = 8; u.keep = 0; u.pm = pm; u.pn = pn; u.aux = e; u.slot = i & 1; return true;
    }
    __device__ __forceinline__ void bias_issue(const GUnit& u, int lane) const {
        __builtin_amdgcn_global_load_lds((const unsigned*)(bdn + (size_t)u.aux * 2048 + u.pn * 256 + lane * 4), (LAS unsigned*)(misc + 4096 + u.slot * 1024), 16, 0, 0); }
    template <class HOIST> __device__ __forceinline__ void epi(EPI_ARGS) const {
        hoist();
        const LAS float* bias = (const LAS float*)(misc + 4096 + u.slot * 1024) + wc * 64 + 16 * fq; f32x4 bv[4];
#pragma unroll
        for (int j = 0; j < 4; ++j) bv[j] = *(const LAS f32x4*)(bias + 4 * j) * FP8_SO;
        EPI_ROWS( *(u32x4*)(op + (size_t)(u.pm * 256 + lrow) * 2048 + u.pn * 256 + lcol) = pk_fp8x16(v0 * (FP8_DESCALE * FP8_SO) + bv[0], v1 * (FP8_DESCALE * FP8_SO) + bv[1], v2 * (FP8_DESCALE * FP8_SO) + bv[2], v3 * (FP8_DESCALE * FP8_SO) + bv[3], 1.0f); )
    }
};

constexpr int SWA_KS = 144, SWA_VS = 528, SWA_VOFF = 256 * SWA_KS;
__device__ __forceinline__ void swa_unit(Frame& F, int unit, const bf16* q, const bf16* kv, const float* sinks, unsigned char* mix) {
    const int b = unit >> 5, nb = (unit >> 1) & 15, kvh = unit & 1, tok0 = b * 2048 + nb * 128, tid = F.tid, lane = F.lane, l15 = lane & 15, quad = lane >> 4;
    LAS unsigned char* Ks = F.lds; LAS unsigned char* Vt = F.lds + SWA_VOFF;
    __syncthreads();
    { u32x4 kr[4], va[2], vb[2];
#pragma unroll
      for (int i = 0; i < 4; ++i) { const int cid = tid + 512 * i, key = cid >> 3, c8 = cid & 7; const bool ok = (nb > 0) || (key >= 128);
          kr[i] = *(const u32x4*)(kv + (size_t)(tok0 + (ok ? key - 128 : 0)) * 256 + kvh * 64 + c8 * 8); }
#pragma unroll
      for (int i = 0; i < 2; ++i) { const int task = tid + 512 * i, kp = task >> 3, c8 = task & 7; const bool ok = (nb > 0) || (kp >= 64);
          const bf16* p = kv + (size_t)(tok0 + (ok ? 2 * kp - 128 : 0)) * 256 + 128 + kvh * 64 + c8 * 8; va[i] = *(const u32x4*)p; vb[i] = *(const u32x4*)(p + 256); }
#pragma unroll
      for (int i = 0; i < 4; ++i) { const int cid = tid + 512 * i, key = cid >> 3, c8 = cid & 7; const bool ok = (nb > 0) || (key >= 128);
          *(LAS u32x4*)(Ks + key * SWA_KS + c8 * 16) = ok ? kr[i] : (u32x4){0u, 0u, 0u, 0u}; }
#pragma unroll
      for (int i = 0; i < 2; ++i) { const int task = tid + 512 * i, kp = task >> 3, c8 = task & 7; const bool ok = (nb > 0) || (kp >= 64);
          const u32x4 a4 = ok ? va[i] : (u32x4){0u, 0u, 0u, 0u}, b4 = ok ? vb[i] : (u32x4){0u, 0u, 0u, 0u};
#pragma unroll
          for (int e = 0; e < 4; ++e) { const unsigned lo = (a4[e] & 0xffffu) | (b4[e] << 16), hi = (a4[e] >> 16) | (b4[e] & 0xffff0000u);
              *(LAS unsigned*)(Vt + (c8 * 8 + 2 * e) * SWA_VS + kp * 4) = lo; *(LAS unsigned*)(Vt + (c8 * 8 + 2 * e + 1) * SWA_VS + kp * 4) = hi; } } }
    __syncthreads();
    const int head = kvh * 8 + F.wave; const float sink = sinks[head] * 1.4426950408889634f;
    const bf16* qbase = q + (size_t)(tok0 + l15) * 1024 + head * 64 + quad * 8;
    bf16x8 nq0 = *(const bf16x8*)qbase, nq1 = *(const bf16x8*)(qbase + 32);
    const bool first = (nb == 0);
    for (int qg = 0; qg < 8; ++qg) {
        const int q0 = 16 * qg, tokq = tok0 + q0 + l15;
        const bf16x8 bq0 = nq0, bq1 = nq1;
        if (qg < 7) { const bf16* qp = qbase + (size_t)(16 * (qg + 1)) * 1024; nq0 = *(const bf16x8*)qp; nq1 = *(const bf16x8*)(qp + 32); }
        f32x4 s[10];
#pragma unroll
        for (int kt = 0; kt < 9; ++kt) { const LAS unsigned char* kp = Ks + (q0 + 16 * kt + l15) * SWA_KS + quad * 16;
            f32x4 a = (f32x4){0.f, 0.f, 0.f, 0.f};
            a = __builtin_amdgcn_mfma_f32_16x16x32_bf16(*(const LAS bf16x8*)kp, bq0, a, 0, 0, 0);
            a = __builtin_amdgcn_mfma_f32_16x16x32_bf16(*(const LAS bf16x8*)(kp + 64), bq1, a, 0, 0, 0); s[kt] = a; if (kt & 1) __builtin_amdgcn_sched_barrier(0); }
        s[9] = (f32x4){0.f, 0.f, 0.f, 0.f};
        float mx = sink;
#pragma unroll
        for (int v = 0; v < 4; ++v) { const int kk = 4 * quad + v; s[0][v] = (kk > l15) ? s[0][v] : -1e30f; s[8][v] = (kk <= l15) ? s[8][v] : -1e30f; }
        if (first) {
#pragma unroll
            for (int kt = 0; kt < 9; ++kt)
#pragma unroll
                for (int v = 0; v < 4; ++v) s[kt][v] = (q0 + 16 * kt + 4 * quad + v >= 128) ? s[kt][v] : -1e30f; }
#pragma unroll
        for (int kt = 0; kt < 9; ++kt)
#pragma unroll
            for (int v = 0; v < 4; ++v) mx = fmaxf(mx, s[kt][v]);
        mx = fmaxf(mx, shx(mx, 16, lane)); mx = fmaxf(mx, shx(mx, 32, lane));
        float sum = 0.f;
#pragma unroll
        for (int kt = 0; kt < 9; ++kt)
#pragma unroll
            for (int v = 0; v < 4; ++v) { const float e = __builtin_amdgcn_exp2f(s[kt][v] - mx); s[kt][v] = e; sum += e; }
        sum += shx(sum, 16, lane); sum += shx(sum, 32, lane);
        const float inv = 1.0f / (sum + __builtin_amdgcn_exp2f(sink - mx));
        bf16x8 pb[5];
#pragma unroll
        for (int i = 0; i < 5; ++i) pb[i] = __builtin_bit_cast(bf16x8, pack8(s[2 * i], s[2 * i + 1]));
        unsigned char* op = mix + (size_t)tokq * 2048 + head * 64 + 4 * quad;
#pragma unroll 1
        for (int dt = 0; dt < 4; ++dt) { f32x4 o = (f32x4){0.f, 0.f, 0.f, 0.f};
#pragma unroll
            for (int i = 0; i < 5; ++i) { const LAS unsigned char* vp = Vt + (16 * dt + l15) * SWA_VS + (q0 + 32 * i + 4 * quad) * 2;
                const u32x2 x0 = *(const LAS u32x2*)vp, x1 = (i < 4) ? *(const LAS u32x2*)(vp + 32) : x0;
                const u32x4 av = (u32x4){x0.x, x0.y, x1.x, x1.y};
                o = __builtin_amdgcn_mfma_f32_16x16x32_bf16(__builtin_bit_cast(bf16x8, av), pb[i], o, 0, 0, 0); }
            const float sc8 = inv * FP8_SA; *(unsigned*)(op + 16 * dt) = pk_fp8x4(o[0] * sc8, o[1] * sc8, o[2] * sc8, o[3] * sc8); }
    }
}

constexpr int MA_KS = 272, MA_VS = 528, MA_VOFF = 256 * MA_KS;
__device__ __forceinline__ void memattn_unit(Frame& F, int unit, int l, const bf16* qm, const bf16* mkv, unsigned char* mix) {
    const int b = unit >> 5, head = (unit >> 3) & 3, qc = unit & 7, tid = F.tid, lane = F.lane, l15 = lane & 15, quad = lane >> 4;
    LAS unsigned char* Ks = F.lds; LAS unsigned char* Vt = F.lds + MA_VOFF;
    const bf16* kbase = mkv + (size_t)(b * 256) * 2048 + l * 1024 + head * 128; const bf16* vbase = kbase + 512;
    __syncthreads();
#pragma unroll
    for (int i = 0; i < 8; ++i) { const int cid = tid + 512 * i, key = cid >> 4, c8 = cid & 15;
        *(LAS u32x4*)(Ks + key * MA_KS + c8 * 16) = *(const u32x4*)(kbase + (size_t)key * 2048 + c8 * 8); }
#pragma unroll
    for (int i = 0; i < 4; ++i) { const int task = tid + 512 * i, kp = task >> 4, c8 = task & 15;
        const bf16* p = vbase + (size_t)(2 * kp) * 2048 + c8 * 8; const u32x4 va = *(const u32x4*)p, vb = *(const u32x4*)(p + 2048);
#pragma unroll
        for (int e = 0; e < 4; ++e) { const unsigned lo = (va[e] & 0xffffu) | (vb[e] << 16), hi = (va[e] >> 16) | (vb[e] & 0xffff0000u);
            *(LAS unsigned*)(Vt + (c8 * 8 + 2 * e) * MA_VS + kp * 4) = lo; *(LAS unsigned*)(Vt + (c8 * 8 + 2 * e + 1) * MA_VS + kp * 4) = hi; } }
    __syncthreads();
    for (int gi = 0; gi < 2; ++gi) {
        const int tokq = b * 2048 + qc * 256 + F.wave * 32 + gi * 16 + l15;
        const bf16* qp = qm + (size_t)tokq * 512 + head * 128 + quad * 8;
        bf16x8 bq[4];
#pragma unroll
        for (int s4 = 0; s4 < 4; ++s4) bq[s4] = *(const bf16x8*)(qp + 32 * s4);
        f32x4 s[16];
#pragma unroll
        for (int kt = 0; kt < 16; ++kt) { const LAS unsigned char* kp = Ks + (16 * kt + l15) * MA_KS + quad * 16; f32x4 a = (f32x4){0.f, 0.f, 0.f, 0.f};
#pragma unroll
            for (int s4 = 0; s4 < 4; ++s4) a = __builtin_amdgcn_mfma_f32_16x16x32_bf16(*(const LAS bf16x8*)(kp + 64 * s4), bq[s4], a, 0, 0, 0);
            s[kt] = a; if (kt & 1) __builtin_amdgcn_sched_barrier(0); }
        float mx = -1e30f;
#pragma unroll
        for (int kt = 0; kt < 16; ++kt)
#pragma unroll
            for (int v = 0; v < 4; ++v) mx = fmaxf(mx, s[kt][v]);
        mx = fmaxf(mx, shx(mx, 16, lane)); mx = fmaxf(mx, shx(mx, 32, lane));
        float sum = 0.f;
#pragma unroll
        for (int kt = 0; kt < 16; ++kt)
#pragma unroll
            for (int v = 0; v < 4; ++v) { const float e = __builtin_amdgcn_exp2f(s[kt][v] - mx); s[kt][v] = e; sum += e; }
        sum += shx(sum, 16, lane); sum += shx(sum, 32, lane);
        const float inv = 1.0f / sum;
        bf16x8 pb[8];
#pragma unroll
        for (int i = 0; i < 8; ++i) pb[i] = __builtin_bit_cast(bf16x8, pack8(s[2 * i], s[2 * i + 1]));
        unsigned char* op = mix + (size_t)tokq * 2048 + 1536 + head * 128 + 4 * quad;
#pragma unroll 1
        for (int dt = 0; dt < 8; ++dt) { f32x4 o = (f32x4){0.f, 0.f, 0.f, 0.f};
#pragma unroll
            for (int i = 0; i < 8; ++i) { const LAS unsigned char* vp = Vt + (16 * dt + l15) * MA_VS + (32 * i + 4 * quad) * 2;
                const u32x2 x0 = *(const LAS u32x2*)vp, x1 = *(const LAS u32x2*)(vp + 32); const u32x4 av = (u32x4){x0.x, x0.y, x1.x, x1.y};
                o = __builtin_amdgcn_mfma_f32_16x16x32_bf16(__builtin_bit_cast(bf16x8, av), pb[i], o, 0, 0, 0); }
            const float sc8 = inv * FP8_SA; *(unsigned*)(op + 16 * dt) = pk_fp8x4(o[0] * sc8, o[1] * sc8, o[2] * sc8, o[3] * sc8); }
    }
}

__device__ __forceinline__ void ssm_carry(Frame& F, int l, int gb) {
    const int g = gb >> 4, b = gb & 15, p = F.lane; const f32x2 lam = ((const f32x2*)(F.ws + WS_LAM))[(l * 32 + g) * 64 + p];
    const float* S = (const float*)(F.ws + WS_S) + ((size_t)g * 1024 + b * 64) * 128; bf16* U = (bf16*)(F.ws + WS_U) + ((size_t)g * 1024 + b * 64) * UK + 512;
    float xr = 0.f, xi = 0.f; float sr[16], si[16], nsr[16], nsi[16];
#pragma unroll
    for (int j = 0; j < 16; ++j) { sr[j] = S[(size_t)j * 128 + p]; si[j] = S[(size_t)j * 128 + 64 + p]; }
    for (int c0 = 0; c0 < 64; c0 += 16) {
        const int cn = (c0 + 16 < 64) ? c0 + 16 : c0;
#pragma unroll
        for (int j = 0; j < 16; ++j) { nsr[j] = S[(size_t)(cn + j) * 128 + p]; nsi[j] = S[(size_t)(cn + j) * 128 + 64 + p]; }
        asm volatile("" ::: "memory");
#pragma unroll
        for (int j = 0; j < 16; ++j) { U[(size_t)(c0 + j) * UK + p] = (bf16)(pk2(xr, 0.f) & 0xffffu); U[(size_t)(c0 + j) * UK + 64 + p] = (bf16)(pk2(xi, 0.f) & 0xffffu);
            const float nr = lam[0] * xr - lam[1] * xi + sr[j], ni = lam[0] * xi + lam[1] * xr + si[j]; xr = nr; xi = ni; }
#pragma unroll
        for (int j = 0; j < 16; ++j) { sr[j] = nsr[j]; si[j] = nsi[j]; } }
}

__device__ __forceinline__ void ln1_router_phase(Frame& F, const Args& a, int l, int probe) {
    const int lane = F.lane, l15 = lane & 15, quad = lane >> 4, w = F.wave, tid = F.tid;
    LAS f32x2* st = (LAS f32x2*)(F.lds);
    LAS float* lgp = (LAS float*)(F.lds + 1024);
    LAS float* lgall = (LAS float*)(F.lds + 49152);
    LAS int* hist = (LAS int*)(F.lds + 66560); LAS int* ebase = (LAS int*)(F.lds + 66688);
    LAS float* gL = (LAS float*)(F.lds + 32768);
    LAS float* bL = (LAS float*)(F.lds + 32768 + 8192);
    __syncthreads();
    for (int i = tid; i < D; i += NTHR) { gL[i] = a.in[18][l * D + i]; bL[i] = a.in[19][l * D + i]; }
    __syncthreads();
    bf16* hb = (bf16*)(F.ws + WS_HB); bf16* hbo = probe ? (bf16*)(F.ws + WS_ACT) : hb; unsigned char* h8o = probe ? (unsigned char*)(F.ws + WS_OP) : (unsigned char*)(F.ws + WS_H8);
    const bf16* whi = (const bf16*)(F.ws + WS_WRT) + (size_t)(l * 2 + 0) * NE * D + 256 * w + 16 * quad; const bf16* wlo = whi + (size_t)NE * D;
    const int cbase = 256 * w + 16 * quad;
    u32x4 raw[8];
    const float rbias = a.in[21][l * NE + (tid & 31)];
    int tile = F.vcu, step = 0;
    if (tile < T / 16) { const bf16* bp = hb + (size_t)(tile * 16 + l15) * D + cbase;
#pragma unroll
        for (int s = 0; s < 8; ++s) raw[s] = *(const u32x4*)(bp + 64 * (s >> 1) + 8 * (s & 1)); }
    for (; tile < T / 16; tile += F.G) {
        bf16* bp = hb + (size_t)(tile * 16 + l15) * D + cbase;
        f32x4 y[8][2]; float sm = 0.f, sq = 0.f;
#pragma unroll
        for (int s = 0; s < 8; ++s) { y[s][0] = (f32x4){bflo(raw[s].x), bfhi(raw[s].x), bflo(raw[s].y), bfhi(raw[s].y)}; y[s][1] = (f32x4){bflo(raw[s].z), bfhi(raw[s].z), bflo(raw[s].w), bfhi(raw[s].w)};
#pragma unroll
            for (int h2 = 0; h2 < 2; ++h2) { const f32x4 v = y[s][h2]; sm += (v[0] + v[1]) + (v[2] + v[3]); sq += (v[0] * v[0] + v[1] * v[1]) + (v[2] * v[2] + v[3] * v[3]); } }
        bf16x8 rw[2][4];
#define LN1_RW_LOAD(slot, s_) do { const int so_ = 64 * ((s_) >> 1) + 8 * ((s_) & 1); \
            rw[slot][0] = *(const bf16x8*)(whi + (size_t)l15 * D + so_); rw[slot][1] = *(const bf16x8*)(whi + (size_t)(16 + l15) * D + so_); \
            rw[slot][2] = *(const bf16x8*)(wlo + (size_t)l15 * D + so_); rw[slot][3] = *(const bf16x8*)(wlo + (size_t)(16 + l15) * D + so_); } while (0)
        LN1_RW_LOAD(0, 0); LN1_RW_LOAD(1, 1);
        asm volatile("" ::: "memory");
        { const int nt = tile + F.G; if (nt < T / 16) { const bf16* np = hb + (size_t)(nt * 16 + l15) * D + cbase;
#pragma unroll
            for (int s = 0; s < 8; ++s) raw[s] = *(const u32x4*)(np + 64 * (s >> 1) + 8 * (s & 1)); } }
        sm += shx(sm, 16, lane); sm += shx(sm, 32, lane); sq += shx(sq, 16, lane); sq += shx(sq, 32, lane);
        if (quad == 0) st[w * 16 + l15] = (f32x2){sm, sq};
        __syncthreads();
        float ts = 0.f, tq = 0.f;
#pragma unroll
        for (int k = 0; k < 8; ++k) { const f32x2 v = st[k * 16 + l15]; ts += v[0]; tq += v[1]; }
        const float mean = ts * (1.f / D), var = fmaxf(tq * (1.f / D) - mean * mean, 0.f), rstd = 1.f / sqrtf(var + LN_EPS);
        if (w == 0 && quad == 0 && !probe) ((f32x2*)(F.ws + WS_RS))[tile * 16 + l15] = (f32x2){mean, rstd};
        f32x4 acc0 = (f32x4){0.f, 0.f, 0.f, 0.f}, acc1 = acc0; u32x2 q8prev = (u32x2){0u, 0u}; u32x4 h8w[4];
#pragma unroll
        for (int s = 0; s < 8; ++s) { const int so = 64 * (s >> 1) + 8 * (s & 1), c0 = cbase + so;
            const f32x4 g0 = *(const LAS f32x4*)(gL + c0), g1 = *(const LAS f32x4*)(gL + c0 + 4), b0 = *(const LAS f32x4*)(bL + c0), b1 = *(const LAS f32x4*)(bL + c0 + 4);
            const f32x4 y0 = (y[s][0] - mean) * rstd * g0 + b0, y1 = (y[s][1] - mean) * rstd * g1 + b1;
            const u32x4 hi = pack8(y0, y1);
            { u32x2 q8; q8.x = pk_fp8x4(y0[0] * FP8_SA, y0[1] * FP8_SA, y0[2] * FP8_SA, y0[3] * FP8_SA); q8.y = pk_fp8x4(y1[0] * FP8_SA, y1[1] * FP8_SA, y1[2] * FP8_SA, y1[3] * FP8_SA);
              if (s & 1) h8w[s >> 1] = (u32x4){q8prev.x, q8prev.y, q8.x, q8.y}; else q8prev = q8; }
            f32x4 d0, d1;
#pragma unroll
            for (int j = 0; j < 2; ++j) { d0[2 * j] = y0[2 * j] - bflo(hi[j]); d0[2 * j + 1] = y0[2 * j + 1] - bfhi(hi[j]); d1[2 * j] = y1[2 * j] - bflo(hi[2 + j]); d1[2 * j + 1] = y1[2 * j + 1] - bfhi(hi[2 + j]); }
            const bf16x8 ahi = __builtin_bit_cast(bf16x8, hi), alo = __builtin_bit_cast(bf16x8, pack8(d0, d1));
            const bf16x8 bh0 = rw[s & 1][0], bh1 = rw[s & 1][1], bl0 = rw[s & 1][2], bl1 = rw[s & 1][3];
            if (s + 2 < 8) LN1_RW_LOAD(s & 1, s + 2);
            acc0 = __builtin_amdgcn_mfma_f32_16x16x32_bf16(ahi, bh0, acc0, 0, 0, 0); acc0 = __builtin_amdgcn_mfma_f32_16x16x32_bf16(alo, bh0, acc0, 0, 0, 0); acc0 = __builtin_amdgcn_mfma_f32_16x16x32_bf16(ahi, bl0, acc0, 0, 0, 0);
            acc1 = __builtin_amdgcn_mfma_f32_16x16x32_bf16(ahi, bh1, acc1, 0, 0, 0); acc1 = __builtin_amdgcn_mfma_f32_16x16x32_bf16(alo, bh1, acc1, 0, 0, 0); acc1 = __builtin_amdgcn_mfma_f32_16x16x32_bf16(ahi, bl1, acc1, 0, 0, 0); }
#undef LN1_RW_LOAD
#pragma unroll
        for (int k = 0; k < 4; ++k) *(u32x4*)(h8o + (size_t)(tile * 16 + l15) * D + cbase + 64 * k) = h8w[k];
#pragma unroll
        for (int v = 0; v < 4; ++v) { lgp[w * 528 + (4 * quad + v) * 33 + l15] = acc0[v]; lgp[w * 528 + (4 * quad + v) * 33 + 16 + l15] = acc1[v]; }
        __syncthreads();
        { const int r = tid >> 5, e = tid & 31; float t = rbias;
#pragma unroll
          for (int k = 0; k < 8; ++k) t += lgp[k * 528 + r * 33 + e];
          lgall[step * 528 + r * 33 + e] = t; }
        ++step;
    }
    if (probe) { __syncthreads(); return; }
    if (tid < 32) hist[tid] = 0;
    __syncthreads();
    const int nrows = step * 16; int bi[4] = {0, 0, 0, 0}; float gt[4] = {0.f, 0.f, 0.f, 0.f}; int rk[4] = {0, 0, 0, 0}; int row = 0;
    if (tid < nrows) { const int st_ = tid >> 4, r = tid & 15; row = (F.vcu + st_ * F.G) * 16 + r; float bv[4] = {-3e38f, -3e38f, -3e38f, -3e38f};
        for (int e = 0; e < 32; ++e) { float v = lgall[st_ * 528 + r * 33 + e]; int id = e;
#pragma unroll
            for (int k = 0; k < 4; ++k) { if (v > bv[k]) { const float tv = bv[k]; const int ti = bi[k]; bv[k] = v; bi[k] = id; v = tv; id = ti; } } }
        const float e1 = __expf(bv[1] - bv[0]), e2 = __expf(bv[2] - bv[0]), e3 = __expf(bv[3] - bv[0]), inv = 1.0f / (1.0f + e1 + e2 + e3); gt[0] = inv; gt[1] = e1 * inv; gt[2] = e2 * inv; gt[3] = e3 * inv;
#pragma unroll
        for (int k = 0; k < 4; ++k) rk[k] = __hip_atomic_fetch_add(&hist[bi[k]], 1, __ATOMIC_RELAXED, __HIP_MEMORY_SCOPE_WORKGROUP); }
    __syncthreads();
    if (tid < 32) { const int c = hist[tid]; ebase[tid] = c ? (int)__hip_atomic_fetch_add(F.ctl + CW_CNT + (l * 32 + tid) * 64, (unsigned)c, RLX_AGENT) : 0; }
    __syncthreads();
    if (tid < nrows) { int* pe = (int*)(F.ws + WS_PE); int* ps = (int*)(F.ws + WS_PS); float* pg = (float*)(F.ws + WS_PG); int* list = (int*)(F.ws + WS_LIST);
#pragma unroll
        for (int k = 0; k < 4; ++k) { const int e = bi[k], slot = ebase[e] + rk[k]; pe[row * 4 + k] = e; ps[row * 4 + k] = slot; pg[row * 4 + k] = gt[k]; list[e * 32768 + slot] = row; } }
    __syncthreads();
}

__device__ __forceinline__ void combine_ln2_phase(Frame& F, const Args& a, int l, int gw, int NGW, int probe) {
    const int lane = F.lane; const int* pe = (const int*)(F.ws + WS_PE); const int* ps = (const int*)(F.ws + WS_PS); const float* pg = (const float*)(F.ws + WS_PG);
    volatile LAS int* tst = (volatile LAS int*)(F.lds + MISC_OFF + MO_TST); const unsigned char* op = (const unsigned char*)(F.ws + WS_OP); bf16* hb = (bf16*)(F.ws + WS_HB);
    const float* g = a.in[26] + l * D; const float* b = a.in[27] + l * D;
    f32x4 g1v[8], b1v[8];
#pragma unroll
    for (int j = 0; j < 4; ++j) { const int c = 8 * lane + 512 * j; g1v[2 * j] = *(const f32x4*)(a.in[18] + l * D + c); g1v[2 * j + 1] = *(const f32x4*)(a.in[18] + l * D + c + 4);
        b1v[2 * j] = *(const f32x4*)(a.in[19] + l * D + c); b1v[2 * j + 1] = *(const f32x4*)(a.in[19] + l * D + c + 4); }
    const f32x2* rs = (const f32x2*)(F.ws + WS_RS);
    int row = gw; if (row >= T) return;
    typedef int i32x4 __attribute__((ext_vector_type(4)));
    i32x4 e4 = *(const i32x4*)(pe + row * 4), s4 = *(const i32x4*)(ps + row * 4); f32x4 g4 = *(const f32x4*)(pg + row * 4);
    for (; row < T; row += NGW) {
        const int nrow = row + NGW; i32x4 ne4 = e4, ns4 = s4; f32x4 ng4 = g4;
        if (nrow < T) { ne4 = *(const i32x4*)(pe + nrow * 4); ns4 = *(const i32x4*)(ps + nrow * 4); ng4 = *(const f32x4*)(pg + nrow * 4); }
        u32x4 hw[4]; u32x2 ow[4][4]; const f32x2 st = rs[row];
#pragma unroll
        for (int j = 0; j < 4; ++j) hw[j] = *(const u32x4*)(hb + (size_t)row * D + 8 * lane + 512 * j);
#pragma unroll
        for (int k = 0; k < 4; ++k) { const unsigned char* r = op + ((size_t)tst[e4[k]] * 256 + s4[k]) * 2048 + 8 * lane;
#pragma unroll
            for (int j = 0; j < 4; ++j) ow[k][j] = *(const u32x2*)(r + 512 * j); }
        f32x4 v[8]; float s = 0.f;
#pragma unroll
        for (int j = 0; j < 4; ++j) { const float ms = st[0], rr = st[1] * DN_ALPHA;
            v[2 * j] = ((f32x4){bflo(hw[j].x), bfhi(hw[j].x), bflo(hw[j].y), bfhi(hw[j].y)} - ms) * rr * g1v[2 * j] + b1v[2 * j] * DN_ALPHA;
            v[2 * j + 1] = ((f32x4){bflo(hw[j].z), bfhi(hw[j].z), bflo(hw[j].w), bfhi(hw[j].w)} - ms) * rr * g1v[2 * j + 1] + b1v[2 * j + 1] * DN_ALPHA;
#pragma unroll
            for (int k = 0; k < 4; ++k) { const u32x2 w = ow[k][j]; const float gk = g4[k] * (1.0f / FP8_SO);
                const f32x2 a0 = __builtin_amdgcn_cvt_pk_f32_fp8(w.x, false), a1 = __builtin_amdgcn_cvt_pk_f32_fp8(w.x, true), a2 = __builtin_amdgcn_cvt_pk_f32_fp8(w.y, false), a3 = __builtin_amdgcn_cvt_pk_f32_fp8(w.y, true);
                v[2 * j] += (f32x4){a0[0], a0[1], a1[0], a1[1]} * gk; v[2 * j + 1] += (f32x4){a2[0], a2[1], a3[0], a3[1]} * gk; } }
#pragma unroll
        for (int j = 0; j < 8; ++j) s += (v[j][0] + v[j][1]) + (v[j][2] + v[j][3]);
        const float mean = wave_sum(s, lane) * (1.f / D); float s2 = 0.f;
#pragma unroll
        for (int j = 0; j < 8; ++j) { v[j] = v[j] - mean; s2 += (v[j][0] * v[j][0] + v[j][1] * v[j][1]) + (v[j][2] * v[j][2] + v[j][3] * v[j][3]); }
        const float rstd = 1.f / sqrtf(wave_sum(s2, lane) * (1.f / D) + LN_EPS);
#pragma unroll
        for (int j = 0; j < 4; ++j) { const int c = 8 * lane + 512 * j; const f32x4 g0 = *(const f32x4*)(g + c), g1 = *(const f32x4*)(g + c + 4), b0 = *(const f32x4*)(b + c), b1 = *(const f32x4*)(b + c + 4);
            const f32x4 y0 = v[2 * j] * rstd * g0 + b0, y1 = v[2 * j + 1] * rstd * g1 + b1;
            if (probe) { *(u32x4*)((bf16*)(F.ws + WS_ACT) + (size_t)row * D + c) = pack8(y0, y1); if (l == NL - 1) *(u32x4*)((bf16*)(F.ws + WS_MRG) + (size_t)row * D / 2 + c / 2) = pack8(y0, y1); }
            else if (l == NL - 1) { float* o = a.out + (size_t)row * D + c; *(f32x4*)o = y0; *(f32x4*)(o + 4) = y1; }
            else { *(u32x4*)(hb + (size_t)row * D + c) = pack8(y0, y1);
                u32x2 q8; q8.x = pk_fp8x4(y0[0] * FP8_SA, y0[1] * FP8_SA, y0[2] * FP8_SA, y0[3] * FP8_SA); q8.y = pk_fp8x4(y1[0] * FP8_SA, y1[1] * FP8_SA, y1[2] * FP8_SA, y1[3] * FP8_SA);
                *(u32x2*)((unsigned char*)(F.ws + WS_H8) + (size_t)row * D + c) = q8;
                *(unsigned*)((unsigned char*)(F.ws + WS_H4) + (size_t)row * (D / 2) + (c >> 1)) = pk_fp4x8(y0, y1, FP4_SA); } }
        e4 = ne4; s4 = ns4; g4 = ng4;
    }
}

constexpr int PH_PER_LAYER = 11, N_PHASES = 1 + NL * PH_PER_LAYER;
__global__ void __launch_bounds__(NTHR, 2) mk_fwd(Args args) {
    extern __shared__ __attribute__((aligned(16))) unsigned char lds_raw[];
    Frame F;
    F.lds = (LAS unsigned char*)lds_raw; F.MISC = (volatile LAS unsigned*)(F.lds + MISC_OFF);
    F.tid = threadIdx.x; F.lane = F.tid & 63; F.wave = __builtin_amdgcn_readfirstlane(F.tid >> 6);
    F.G = gridDim.x; { const int bx = blockIdx.x; F.vcu = (bx & 7) * (F.G >> 3) + (bx >> 3); }
    F.ws = args.ws; F.ctl = (unsigned*)(args.ws + WS_CTL);
    for (int u = F.tid; u < (LDS_BYTES - MISC_OFF) / 4; u += NTHR) ((LAS unsigned*)(F.lds + MISC_OFF))[u] = 0u;
    __syncthreads();
#if !MK_PER_PHASE
    XcdBarrier bar = xcd_barrier_post(F.ctl + CW_BAR, F.MISC + MO_BAR / 4);
#define GRID_BAR() xcd_barrier(bar)
#else
#define GRID_BAR() do { } while (0)
#endif
    const int lo = args.ph_lo, hi = args.ph_hi;
#ifndef ONLY_PH
#define ONLY_PH -1
#endif
#define EN(o) (ONLY_PH < 0 || ONLY_PH == (o))
#ifndef DBL_MASK
#define DBL_MASK 0
#endif

#define REPS(o) (((DBL_MASK >> (o)) & 1) ? 2 : 1)
#define IN(k) (lo <= (k) && (k) < hi)
#define SEAM(k) do { if (IN(k) && IN((k) + 1)) GRID_BAR(); } while (0)
    const int cidx = (int)blockIdx.x;
#define WS_FRESH2() size_t z2_ = 0; asm volatile("" : "+s"(z2_)); unsigned char* ws2 = args.ws + z2_
#define WS_FRESH() size_t z_ = 0; asm volatile("" : "+s"(z_)); unsigned char* ws = args.ws + z_; F.ws = ws; F.ctl = (unsigned*)(ws + WS_CTL); \
    { int t_ = threadIdx.x; asm volatile("" : "+v"(t_)); F.tid = t_; F.lane = t_ & 63; F.wave = __builtin_amdgcn_readfirstlane(t_ >> 6); \
      int bx_ = blockIdx.x; asm volatile("" : "+s"(bx_)); F.vcu = (bx_ & 7) * (F.G >> 3) + (bx_ >> 3); } \
    const int gw = F.vcu * NWAVES + F.wave, NGW = F.G * NWAVES; (void)gw; (void)NGW

    if (EN(100) && IN(0)) for (int rep_ = 0; rep_ < REPS(11); ++rep_) { WS_FRESH(); p0_prologue(F, args); }
    SEAM(0);
    for (int l = 0; l < NL; ++l) {
        const int pb = 1 + l * PH_PER_LAYER;
        if (EN(0) && IN(pb + 0)) for (int rep_ = 0; rep_ < REPS(0); ++rep_) { WS_FRESH(); asm volatile("; MARK_PHASE_0" ::: "memory");
            PInproj P; P.lda = 2048; P.ldb = 2048; P.hb = (const char*)(ws + WS_H8); P.win = (const char*)(ws + WS_WIN) + (size_t)l * INW * D; P.memb = (const char*)(ws + WS_MEMB); P.wmkv = (const char*)(ws + WS_WMKV);
            P.G = F.G; P.c = cidx; P.nextra = (l == 0) ? 128 : 0; P.mode = 0; P.i0 = 0; P.i1 = 1 << 20;
            P.q = (bf16*)(ws + WS_Q); P.kv = (bf16*)(ws + WS_KV); P.U = (bf16*)(ws + WS_U); P.qm = (bf16*)(ws + WS_QM); P.mkv = (bf16*)(ws + WS_MKV); P.gates = (unsigned char*)(ws + WS_G);
            P.probe_ = (PROBE_VARIANT != 0) ? rep_ : 0;
            pg8::gemm_phase(F.lds, P);
        }
        SEAM(pb + 0);
        if (EN(1) && IN(pb + 1)) for (int rep_ = 0; rep_ < REPS(1); ++rep_) { WS_FRESH(); asm volatile("; MARK_PHASE_1" ::: "memory");
            { PSsmState P; P.lda = UK * 2; P.ldb = 1024; P.U = (const char*)(ws + WS_U); P.Wst = (const char*)(ws + WS_WST) + (size_t)l * 32 * 256 * 1024; P.G = F.G; P.c = cidx; P.S = (float*)(ws + WS_S);
              pg8::gemm_phase(F.lds, P); }
            if (cidx < 128) { if (F.wave < 4) ssm_carry(F, l, (cidx >> 2) * 16 + (cidx & 3) * 4 + F.wave); VM_WAIT(); }
            __syncthreads();
            { PSsmOut P; P.lda = UK * 2; P.ldb = UK * 2; P.U = (const char*)(ws + WS_U); P.W1 = (const char*)(ws + WS_W1S) + (size_t)l * 32 * 512 * UK * 2; P.G = F.G; P.c = cidx; P.z = (bf16*)(ws + WS_Z);
              pg8::gemm_phase(F.lds, P); }
            if (F.G == 256) {
                const int nu = (cidx < 128) ? 1 : 3, u0 = (cidx < 128) ? cidx : 128 + (cidx - 128) * 3;
                for (int j = 0; j < nu; ++j) swa_unit(F, u0 + j, (const bf16*)(ws + WS_Q), (const bf16*)(ws + WS_KV), args.in[5] + l * 16, (unsigned char*)(ws + WS_MIX));
                for (int j = 0; j < nu; ++j) memattn_unit(F, u0 + j, l, (const bf16*)(ws + WS_QM), (const bf16*)(ws + WS_MKV), (unsigned char*)(ws + WS_MIX));
            } else {
                for (int u = F.vcu; u < 512; u += F.G) swa_unit(F, u, (const bf16*)(ws + WS_Q), (const bf16*)(ws + WS_KV), args.in[5] + l * 16, (unsigned char*)(ws + WS_MIX));
                for (int u = F.vcu; u < 512; u += F.G) memattn_unit(F, u, l, (const bf16*)(ws + WS_QM), (const bf16*)(ws + WS_MKV), (unsigned char*)(ws + WS_MIX));
            }
        }
        SEAM(pb + 1);
        if (EN(4) && IN(pb + 4)) for (int rep_ = 0; rep_ < REPS(4); ++rep_) { WS_FRESH(); asm volatile("; MARK_PHASE_4" ::: "memory");
            { PGlu P; P.lda = 1024; P.ldb = 1024; P.z = (const char*)(ws + WS_Z); P.wg = (const char*)(ws + WS_WGLU) + (size_t)l * 1024 * 512 * 2; P.G = F.G; P.c = cidx; P.mix = (unsigned char*)(ws + WS_MIX);
              pg8::gemm_phase(F.lds, P); }
            { PInGate4 P; P.lda = 1024; P.ldb = 1024; P.h4 = (const char*)(ws + WS_H4); P.win4 = (const char*)(ws + WS_WIN4) + (size_t)l * 6144 * (D / 2); P.G = F.G; P.c = cidx; P.gates = (unsigned char*)(ws + WS_G);
              pg8::gemm_phase(F.lds, P); }
        }
        SEAM(pb + 4);
        if (EN(5) && IN(pb + 5)) for (int rep_ = 0; rep_ < REPS(5); ++rep_) { WS_FRESH(); asm volatile("; MARK_PHASE_5" ::: "memory");
            PBranch P; P.lda = 2048; P.ldb = 2048; P.mix = (const char*)(ws + WS_MIX); P.wb = (const char*)(ws + WS_WBR) + (size_t)l * D * D; P.G = F.G; P.c = cidx; P.gates = (const unsigned char*)(ws + WS_G); P.mrg = (unsigned char*)(ws + WS_MRG);
            pg8::gemm_phase(F.lds, P);
        }
        SEAM(pb + 5);
        if (EN(6) && IN(pb + 6)) { WS_FRESH(); asm volatile("; MARK_PHASE_6" ::: "memory");
            PWout P; P.lda = 2048; P.ldb = 2048; P.mrg = (const char*)(ws + WS_MRG); P.wo = (const char*)(ws + WS_WOUT) + (size_t)l * D * D; P.G = F.G; P.c = cidx; P.h = (bf16*)(ws + WS_HB);
            pg8::gemm_phase(F.lds, P);
        }
        SEAM(pb + 6);
        if (EN(7) && IN(pb + 7)) for (int rep_ = 0; rep_ < REPS(7); ++rep_) { WS_FRESH(); asm volatile("; MARK_PHASE_7" ::: "memory"); ln1_router_phase(F, args, l, rep_); }
        SEAM(pb + 7);
        if (EN(8) && IN(pb + 8)) for (int rep_ = 0; rep_ < REPS(8); ++rep_) { WS_FRESH(); asm volatile("; MARK_PHASE_8" ::: "memory");
            moe_tables(F, l);
            const int rc = (l == 0) ? (cidx * 16) / F.G : 0;
            for (int part = 0; part < 2; ++part) {
                { WS_FRESH2();
                  PMoeUp P; P.lda = 2048; P.ldb = 2048; P.hb = (const char*)(ws2 + WS_H8); P.wup = (const char*)(ws2 + WS_WUP) + (size_t)l * NE * D * D; P.G = F.G; P.c = cidx;
                  P.list = (const int*)(ws2 + WS_LIST); P.bup = args.in[23] + (size_t)l * NE * 2048; P.act = (unsigned char*)(ws2 + WS_ACT); P.misc = F.lds + MISC_OFF;
                  P.i0 = part ? rc : 0; P.i1 = part ? (1 << 20) : rc;
                  pg8::gemm_phase(F.lds, P); }
                if (part == 0 && l == 0) { __syncthreads(); t_run<true>(F, args, 2, gw, NGW); __syncthreads(); } }
        }
        SEAM(pb + 8);
        if (EN(9) && IN(pb + 9)) for (int rep_ = 0; rep_ < REPS(9); ++rep_) { WS_FRESH(); asm volatile("; MARK_PHASE_9" ::: "memory");
            moe_tables(F, l);
            PMoeDown P; P.lda = 1024; P.ldb = 1024; P.act = (const char*)(ws + WS_ACT); P.wdn = (const char*)(ws + WS_WDN) + (size_t)l * NE * D * DFF; P.G = F.G; P.c = cidx;
            P.bdn = args.in[25] + (size_t)l * NE * 2048; P.op = (unsigned char*)(ws + WS_OP); P.misc = F.lds + MISC_OFF;
            pg8::gemm_phase(F.lds, P);
        }
        SEAM(pb + 9);
        if (EN(10) && IN(pb + 10)) { WS_FRESH(); asm volatile("; MARK_PHASE_10" ::: "memory"); moe_tables(F, l); for (int rep_ = REPS(10) - 1; rep_ >= 0; --rep_) combine_ln2_phase(F, args, l, gw, NGW, rep_); }
        SEAM(pb + 10); asm volatile("; MARK_PHASE_END" ::: "memory");
    }
#undef IN
#undef SEAM
}

extern "C" void kernel_launch(void* const* d_in, const int* in_sizes, int n_in, void* d_out, int out_size, void* d_ws, size_t ws_size, hipStream_t stream) {
    static int grid = 0;
    if (grid == 0) {
        if (n_in != 28 || out_size != T * D || ws_size < WS_END) { fprintf(stderr, "kernel_launch: unexpected shapes (n_in %d out %d ws %zu need %zu)\n", n_in, out_size, ws_size, (size_t)WS_END); grid = -1; return; }
        int dev = 0, cus = 0, per_cu = 0;
        if (hipGetDevice(&dev) != hipSuccess || hipDeviceGetAttribute(&cus, hipDeviceAttributeMultiprocessorCount, dev) != hipSuccess) { grid = -1; return; }
        if (hipFuncSetAttribute((const void*)mk_fwd, hipFuncAttributeMaxDynamicSharedMemorySize, LDS_BYTES) != hipSuccess) { fprintf(stderr, "kernel_launch: hipFuncSetAttribute failed\n"); grid = -1; return; }
        if (hipOccupancyMaxActiveBlocksPerMultiprocessor(&per_cu, (const void*)mk_fwd, NTHR, LDS_BYTES) != hipSuccess || per_cu < 1) fprintf(stderr, "kernel_launch: occupancy query reports %d\n", per_cu);
        (void)hipGetLastError();
        grid = cus;
        if (cus != 256) { fprintf(stderr, "kernel_launch: built for a 256-CU MI355X (found %d CUs); nothing launched\n", cus); grid = -1; return; }
    }
    if (grid < 0) return;
    if (hipMemsetAsync((char*)d_ws + WS_CTL, 0, CTL_ZERO_BYTES, stream) != hipSuccess) return;
    Args a{};
    for (int i = 0; i < 28; ++i) a.in[i] = (const float*)d_in[i];
    a.out = (float*)d_out; a.ws = (unsigned char*)d_ws;
#if MK_PER_PHASE
    for (int p = 0; p < N_PHASES; ++p) { a.ph_lo = p; a.ph_hi = p + 1; hipLaunchKernelGGL(mk_fwd, dim3(grid), dim3(NTHR), LDS_BYTES, stream, a); }
#else
    a.ph_lo = 0; a.ph_hi = N_PHASES; hipLaunchKernelGGL(mk_fwd, dim3(grid), dim3(NTHR), LDS_BYTES, stream, a);
#endif
}
```
